# Optimizing an MI355X kernel written in HIP

```python
import math
import jax, jax.numpy as jnp
from jax import lax
import numpy as np

D_MODEL = 2048
BATCH = 4
SEQ = 4096
DEPTH = 1

MIX_WIDTH = D_MODEL
POOL_WIDTH = MIX_WIDTH // 2
LRU_WIDTH = MIX_WIDTH - POOL_WIDTH
POOL_WINDOWS = (2, 4, 8, 16)
N_POOL_GROUPS = len(POOL_WINDOWS)
POOL_GROUP = POOL_WIDTH // N_POOL_GROUPS
LRU_HEADS = 8
LRU_HEAD_DIM = LRU_WIDTH // LRU_HEADS
CONV_WIDTH = 4
LRU_C = 8.0
N_MEM = 256
XATTN_HEADS = 4
XATTN_HEAD_DIM = D_MODEL // XATTN_HEADS
D_FF = 4 * D_MODEL
LN_EPS = 1e-5
DEEPNORM_ALPHA = (2.0 * DEPTH) ** 0.25
DEEPNORM_BETA = (8.0 * DEPTH) ** -0.25

kernel_name = "hymba_pool_rglru_deepnorm_layer"


def layer_norm(x, g, b):
    xf = x.astype(jnp.float32)
    mu = jnp.mean(xf, axis=-1, keepdims=True)
    var = jnp.mean(jnp.square(xf - mu), axis=-1, keepdims=True)
    y = (xf - mu) * lax.rsqrt(var + LN_EPS)
    return (y * g.astype(jnp.float32) + b.astype(jnp.float32)).astype(x.dtype)


def multiscale_pool(u, w_pool, b_pool, pool_scale):
    B, S, _ = u.shape
    uf = u.astype(jnp.float32).reshape(B, S, N_POOL_GROUPS, POOL_GROUP)
    csum = jnp.cumsum(uf, axis=1)
    t = jnp.arange(S)
    means = []
    for g, w in enumerate(POOL_WINDOWS):
        c = csum[:, :, g]
        c_prev = jnp.pad(c, ((0, 0), (w, 0), (0, 0)))[:, :S]
        cnt = jnp.minimum(t + 1, w).astype(jnp.float32)[None, :, None]
        means.append((c - c_prev) / cnt)
    mixed = (jnp.stack(means, axis=2) - uf).astype(u.dtype)
    y = jnp.einsum('bsgc,gcd->bsgd', mixed, w_pool) + b_pool
    return y.reshape(B, S, POOL_WIDTH) * pool_scale


def causal_depthwise_conv(x, w, b):
    S = x.shape[1]
    xp = jnp.pad(x, ((0, 0), (CONV_WIDTH - 1, 0), (0, 0)))
    y = xp[:, 0:S] * w[0]
    for k in range(1, CONV_WIDTH):
        y = y + xp[:, k:k + S] * w[k]
    return y + b


def rg_lru(x, w_a, b_a, w_x, b_x, lam):
    B, S, _ = x.shape
    xh = x.reshape(B, S, LRU_HEADS, LRU_HEAD_DIM)
    r = jax.nn.sigmoid(jnp.einsum('bshi,hij->bshj', xh, w_a) + b_a).reshape(B, S, LRU_WIDTH)
    i = jax.nn.sigmoid(jnp.einsum('bshi,hij->bshj', xh, w_x) + b_x).reshape(B, S, LRU_WIDTH)
    log_a = -LRU_C * r.astype(jnp.float32) * jax.nn.softplus(-lam.astype(jnp.float32))
    a = jnp.exp(log_a)
    mult = jnp.sqrt(-jnp.expm1(2.0 * log_a))
    mult = jnp.where((jnp.arange(S) == 0)[None, :, None], 1.0, mult)
    bterm = mult * (i * x).astype(jnp.float32)

    def combine(lhs, rhs):
        a1, b1 = lhs
        a2, b2 = rhs
        return a1 * a2, a2 * b1 + b2

    _, h = lax.associative_scan(combine, (a, bterm), axis=1)
    return h.astype(x.dtype)


def hybrid_mixer(x, w_in, conv_w, conv_b, w_a, b_a, w_x, b_x, lam,
                 w_pool, b_pool, pool_scale, w_out):
    proj = x @ w_in
    u_pool = proj[..., :POOL_WIDTH]
    u_lru = proj[..., POOL_WIDTH:POOL_WIDTH + LRU_WIDTH]
    u_gate = proj[..., POOL_WIDTH + LRU_WIDTH:]
    y_pool = multiscale_pool(u_pool, w_pool, b_pool, pool_scale)
    h = rg_lru(causal_depthwise_conv(u_lru, conv_w, conv_b), w_a, b_a, w_x, b_x, lam)
    y_lru = h * jax.nn.gelu(u_gate)
    return jnp.concatenate([y_pool, y_lru], axis=-1) @ w_out


def memory_cross_attention(x, mem, w_q, w_k, w_v, w_o):
    B, S, _ = x.shape
    M = mem.shape[1]
    q = (x @ w_q).reshape(B, S, XATTN_HEADS, XATTN_HEAD_DIM)
    k = (mem @ w_k).reshape(B, M, XATTN_HEADS, XATTN_HEAD_DIM)
    v = (mem @ w_v).reshape(B, M, XATTN_HEADS, XATTN_HEAD_DIM)
    s = jnp.einsum('bqhd,bmhd->bhqm', q, k).astype(jnp.float32) * (XATTN_HEAD_DIM ** -0.5)
    p = jax.nn.softmax(s, axis=-1).astype(v.dtype)
    o = jnp.einsum('bhqm,bmhd->bqhd', p, v).reshape(B, S, D_MODEL)
    return o @ w_o


def squared_relu_mlp(x, w1, w2):
    return jnp.square(jax.nn.relu(x @ w1)) @ w2


def setup_inputs(seed: int = 0) -> dict:
    key = jax.random.key(seed)
    ks = jax.random.split(key, 32)
    f32 = jnp.float32

    def nrm(k, shape, scale):
        return jax.random.normal(k, shape, f32) * scale

    L = DEPTH
    u = jax.random.uniform(ks[10], (L, LRU_WIDTH), f32, 0.9, 0.999)
    s = u ** (1.0 / LRU_C)
    lam = jnp.log(s) - jnp.log1p(-s)
    return {
        "x": nrm(ks[0], (BATCH, SEQ, D_MODEL), 1.0),
        "mem": nrm(ks[1], (BATCH, N_MEM, D_MODEL), 1.0),
        "w_in": nrm(ks[2], (L, D_MODEL, POOL_WIDTH + 2 * LRU_WIDTH), D_MODEL ** -0.5),
        "conv_w": nrm(ks[3], (L, CONV_WIDTH, LRU_WIDTH), CONV_WIDTH ** -0.5),
        "conv_b": nrm(ks[4], (L, LRU_WIDTH), 0.01),
        "w_a": nrm(ks[5], (L, LRU_HEADS, LRU_HEAD_DIM, LRU_HEAD_DIM), LRU_HEAD_DIM ** -0.5),
        "b_a": nrm(ks[6], (L, LRU_HEADS, LRU_HEAD_DIM), 0.01),
        "w_x": nrm(ks[7], (L, LRU_HEADS, LRU_HEAD_DIM, LRU_HEAD_DIM), LRU_HEAD_DIM ** -0.5),
        "b_x": nrm(ks[8], (L, LRU_HEADS, LRU_HEAD_DIM), 0.01),
        "lru_lambda": lam,
        "w_pool": nrm(ks[11], (L, N_POOL_GROUPS, POOL_GROUP, POOL_GROUP), POOL_GROUP ** -0.5),
        "b_pool": nrm(ks[12], (L, N_POOL_GROUPS, POOL_GROUP), 0.01),
        "pool_scale": 1.0 + nrm(ks[13], (L, POOL_WIDTH), 0.1),
        "w_out": nrm(ks[14], (L, MIX_WIDTH, D_MODEL), MIX_WIDTH ** -0.5 * DEEPNORM_BETA),
        "ln1_g": 1.0 + nrm(ks[15], (L, D_MODEL), 0.05),
        "ln1_b": nrm(ks[16], (L, D_MODEL), 0.01),
        "w_q": nrm(ks[17], (L, D_MODEL, D_MODEL), D_MODEL ** -0.5),
        "w_k": nrm(ks[18], (L, D_MODEL, D_MODEL), D_MODEL ** -0.5),
        "w_v": nrm(ks[19], (L, D_MODEL, D_MODEL), D_MODEL ** -0.5 * DEEPNORM_BETA),
        "w_o": nrm(ks[20], (L, D_MODEL, D_MODEL), D_MODEL ** -0.5 * DEEPNORM_BETA),
        "ln2_g": 1.0 + nrm(ks[21], (L, D_MODEL), 0.05),
        "ln2_b": nrm(ks[22], (L, D_MODEL), 0.01),
        "w_ff1": nrm(ks[23], (L, D_MODEL, D_FF), D_MODEL ** -0.5 * DEEPNORM_BETA),
        "w_ff2": nrm(ks[24], (L, D_FF, D_MODEL), D_FF ** -0.5 * DEEPNORM_BETA),
        "ln3_g": 1.0 + nrm(ks[25], (L, D_MODEL), 0.05),
        "ln3_b": nrm(ks[26], (L, D_MODEL), 0.01),
    }


def reference(x, mem, w_in, conv_w, conv_b, w_a, b_a, w_x, b_x, lru_lambda,
              w_pool, b_pool, pool_scale, w_out, ln1_g, ln1_b,
              w_q, w_k, w_v, w_o, ln2_g, ln2_b, w_ff1, w_ff2, ln3_g, ln3_b):
    for l in range(DEPTH):
        y = hybrid_mixer(x, w_in[l], conv_w[l], conv_b[l], w_a[l], b_a[l], w_x[l], b_x[l],
                         lru_lambda[l], w_pool[l], b_pool[l], pool_scale[l], w_out[l])
        x = layer_norm(DEEPNORM_ALPHA * x + y, ln1_g[l], ln1_b[l])
        y = memory_cross_attention(x, mem, w_q[l], w_k[l], w_v[l], w_o[l])
        x = layer_norm(DEEPNORM_ALPHA * x + y, ln2_g[l], ln2_b[l])
        y = squared_relu_mlp(x, w_ff1[l], w_ff2[l])
        x = layer_norm(DEEPNORM_ALPHA * x + y, ln3_g[l], ln3_b[l])
    return x
```

```cpp
#include <hip/hip_runtime.h>
#include <hip/hip_cooperative_groups.h>
#include <cstdio>
#include <cstdint>
namespace cg = cooperative_groups;

#ifndef PROBE_DUP_MASK
#define PROBE_DUP_MASK 0
#endif
#ifndef PROBE_LN
#define PROBE_LN 0
#endif
#ifndef PROBE_PREFIX
#define PROBE_PREFIX -1
#endif
#ifndef MK_N_LAUNCHES
#define MK_N_LAUNCHES 1
#endif

#define LAS __attribute__((address_space(3)))
typedef unsigned short bf16_t;
typedef short bf16x8 __attribute__((ext_vector_type(8)));
typedef float f32x4 __attribute__((ext_vector_type(4)));
typedef float f32x2 __attribute__((ext_vector_type(2)));
typedef unsigned u32x4 __attribute__((ext_vector_type(4)));
typedef unsigned u32x2 __attribute__((ext_vector_type(2)));
typedef _Float16 f16x2 __attribute__((ext_vector_type(2)));

constexpr int T = 16384, SEQ = 4096, D = 2048, NPROJ = 3072, DFF = 8192, NMEMROWS = 1024;
constexpr float LN_EPS = 1e-5f;
constexpr float ALPHA = 1.189207115002721f;

constexpr size_t MiB = 1u << 20;
constexpr size_t WS_CTL = 0, CTL_BYTES = 1 * MiB;
constexpr size_t WS_WFF1 = 2 * MiB, WS_WFF2 = 34 * MiB, WS_WIN = 66 * MiB, WS_WOUT = 78 * MiB, WS_WQ = 86 * MiB, WS_WK = 94 * MiB, WS_WV = 102 * MiB, WS_WO = 110 * MiB;
constexpr size_t WS_Y3 = 66 * MiB;
constexpr size_t WS_WPOOL = 118 * MiB, WS_WAX = 118 * MiB + 512 * 1024;
constexpr size_t WS_MEMB = 119 * MiB, WS_KB = 123 * MiB, WS_VT = 127 * MiB;
constexpr size_t WS_XB = 131 * MiB;
constexpr size_t WS_BF = 131 * MiB;
constexpr size_t WS_PROJ = 195 * MiB;
constexpr size_t WS_Q = 195 * MiB;
constexpr size_t WS_PB = 259 * MiB;
constexpr size_t WS_A2 = 291 * MiB;
constexpr size_t WS_SUM = 291 * MiB;
constexpr size_t WS_O = 291 * MiB;
constexpr size_t WS_MIX = 355 * MiB;
constexpr size_t WS_AF = 419 * MiB;
constexpr size_t WS_H = 195 * MiB;
constexpr size_t WS_END = 483 * MiB;

constexpr int LDS_BYTES = 147456;
constexpr int LDS_X = 131072;
constexpr int LDS_BARST = 131072 + 8192;

__device__ __forceinline__ unsigned cvt_pk_bf16(float lo, float hi) { unsigned r; asm volatile("v_cvt_pk_bf16_f32 %0, %1, %2" : "=v"(r) : "v"(lo), "v"(hi)); return r; }
__device__ __forceinline__ float bf_lo(unsigned w) { return __uint_as_float(w << 16); }
__device__ __forceinline__ float bf_hi(unsigned w) { return __uint_as_float(w & 0xffff0000u); }
__device__ __forceinline__ float bf2f(bf16_t b) { return __uint_as_float(((unsigned)b) << 16); }
__device__ __forceinline__ bf16_t f2bf(float f) { unsigned u = __float_as_uint(f); return (bf16_t)((u + 0x7fffu + ((u >> 16) & 1u)) >> 16); }
__device__ __forceinline__ float wave_sum(float v) {
#pragma unroll
    for (int o = 1; o < 64; o <<= 1) v += __shfl_xor(v, o);
    return v;
}
__device__ __forceinline__ unsigned pk_f16(float lo, float hi) { f16x2 v; v.x = (_Float16)lo; v.y = (_Float16)hi; return __builtin_bit_cast(unsigned, v); }
__device__ __forceinline__ float h_lo(unsigned w) { return (float)__builtin_bit_cast(f16x2, w).x; }
__device__ __forceinline__ float h_hi(unsigned w) { return (float)__builtin_bit_cast(f16x2, w).y; }
__device__ __forceinline__ float sigmoidf_(float x) { return 1.0f / (1.0f + __expf(-x)); }
__device__ __forceinline__ float gelu_tanh(float x) {
    const float z = 0.7978845608028654f * (x + 0.044715f * x * x * x);
    const float e = __expf(2.0f * z);
    const float th = 1.0f - 2.0f / (e + 1.0f);
    return 0.5f * x * (1.0f + th);
}

namespace pg8 {
constexpr int BM = 256, BK = 64, HALF = 128, HTB = HALF * BK * 2, STAGE_BYTES = 8 * HTB, NXCD = 8, WGM = 8;
__host__ __device__ __forceinline__ int lds_byte(int r, int c) { const int st = (r >> 4) * 2 + (c >> 5), rr = r & 15, cc = c & 31, ob = rr * 64 + cc * 2; return st * 1024 + (ob ^ (((ob >> 9) & 1) << 5)); }
__host__ __device__ __forceinline__ void stage_rc(int b, int& R, int& C) { const int st = b / 1024, sb = b % 1024, swz = sb ^ (((sb >> 9) & 1) << 5); R = (st >> 1) * 16 + swz / 64; C = (st & 1) * 32 + (swz % 64) / 2; }
__host__ __device__ __forceinline__ int perm32(int rho) { const int n = rho >> 4, i = rho & 15; return 8 * (i >> 2) + 4 * n + (i & 3); }

struct Unit { int pm, pn, g; };

struct GSched {
    const bf16_t* A; const bf16_t* Bt;
    long ga1, ga0, gb1, gb0; int gdiv;
    int lda, ldb, nMg, nVM, nN, nwg, G, c;
    __device__ __forceinline__ void init(const bf16_t* A_, int lda_, const bf16_t* Bt_, int ldb_, int nG, int nMg_, int nN_, int G_, int c_) {
        A = A_; Bt = Bt_; lda = lda_; ldb = ldb_; nMg = nMg_; nVM = nG * nMg_; nN = nN_; nwg = nVM * nN_; G = G_; c = c_;
        ga1 = ga0 = gb1 = gb0 = 0; gdiv = 1;
    }
    __device__ __forceinline__ bool next(int i, Unit& u) const {
        const long L = (long)i * G + c; if (L >= nwg) return false;
        int wgid = (int)L; { const int q = nwg / NXCD, r = nwg % NXCD, xcd = wgid % NXCD, off = wgid / NXCD; wgid = (xcd < r ? xcd * (q + 1) : r * (q + 1) + (xcd - r) * q) + off; }
        const int nig = WGM * nN, gid = wgid / nig, fm = gid * WGM, gsz = (nVM - fm) < WGM ? (nVM - fm) : WGM;
        const int vm = fm + ((wgid % nig) % gsz); u.pn = (wgid % nig) / gsz; u.g = vm / nMg; u.pm = vm % nMg; return true;
    }
    __device__ __forceinline__ const char* a_ptr(const Unit& u) const { return (const char*)(A + (long)(u.g / gdiv) * ga1 + (long)(u.g % gdiv) * ga0 + (long)u.pm * BM * lda); }
    __device__ __forceinline__ const char* b_ptr(const Unit& u) const { return (const char*)(Bt + (long)(u.g / gdiv) * gb1 + (long)(u.g % gdiv) * gb0 + (long)u.pn * BM * ldb); }
};

struct EpiBf16 {
    static constexpr bool PERM = true;
    bf16_t* O; int ldc; long go1, go0; int gdiv; int act;
    __device__ __forceinline__ void operator()(f32x4 (&acc)[2][2][4][2], const Unit& u, int wr, int wc, int fr, int fq, LAS unsigned char*) const {
        bf16_t* base = O + (long)(u.g / gdiv) * go1 + (long)(u.g % gdiv) * go0 + ((size_t)u.pm * BM + wr * 64 + fr) * ldc + u.pn * BM + wc * 32 + 8 * fq;
#pragma unroll
        for (int ai = 0; ai < 2; ++ai)
#pragma unroll
            for (int m = 0; m < 4; ++m) { bf16_t* rowp = base + (size_t)(ai * HALF + m * 16) * ldc;
#pragma unroll
                for (int bj = 0; bj < 2; ++bj) { f32x4 v0 = acc[ai][bj][m][0], v1 = acc[ai][bj][m][1];
                    if (act == 1) {
#pragma unroll
                        for (int j = 0; j < 4; ++j) { const float a0 = fmaxf(v0[j], 0.f), a1 = fmaxf(v1[j], 0.f); v0[j] = a0 * a0; v1[j] = a1 * a1; } }
                    u32x4 w; w.x = cvt_pk_bf16(v0[0], v0[1]); w.y = cvt_pk_bf16(v0[2], v0[3]); w.z = cvt_pk_bf16(v1[0], v1[1]); w.w = cvt_pk_bf16(v1[2], v1[3]);
                    *(u32x4*)(rowp + bj * HALF) = w; } }
    }
};
struct EpiPool {
    static constexpr bool PERM = true;
    bf16_t* O; const float* bias; const float* scale;
    __device__ __forceinline__ void operator()(f32x4 (&acc)[2][2][4][2], const Unit& u, int wr, int wc, int fr, int fq, LAS unsigned char*) const {
        const int col0 = u.g * 256 + wc * 32 + 8 * fq;
        bf16_t* base = O + ((size_t)u.pm * BM + wr * 64 + fr) * D + col0;
        f32x4 bv[2][2], sv[2][2];
#pragma unroll
        for (int bj = 0; bj < 2; ++bj)
#pragma unroll
            for (int n = 0; n < 2; ++n) { bv[bj][n] = *(const f32x4*)(bias + col0 + bj * HALF + 4 * n); sv[bj][n] = *(const f32x4*)(scale + col0 + bj * HALF + 4 * n); }
#pragma unroll
        for (int ai = 0; ai < 2; ++ai)
#pragma unroll
            for (int m = 0; m < 4; ++m) { bf16_t* rowp = base + (size_t)(ai * HALF + m * 16) * D;
#pragma unroll
                for (int bj = 0; bj < 2; ++bj) { const f32x4 v0 = (acc[ai][bj][m][0] + bv[bj][0]) * sv[bj][0], v1 = (acc[ai][bj][m][1] + bv[bj][1]) * sv[bj][1];
                    u32x4 w; w.x = cvt_pk_bf16(v0[0], v0[1]); w.y = cvt_pk_bf16(v0[2], v0[3]); w.z = cvt_pk_bf16(v1[0], v1[1]); w.w = cvt_pk_bf16(v1[2], v1[3]);
                    *(u32x4*)(rowp + bj * HALF) = w; } }
    }
};
struct EpiLru {
    static constexpr bool PERM = true;
    const bf16_t* A2; const float* b_a; const float* b_x; const float* lam; unsigned short* AH; unsigned short* BH;
    __device__ __forceinline__ void operator()(f32x4 (&acc)[2][2][4][2], const Unit& u, int wr, int wc, int fr, int fq, LAS unsigned char*) const {
        const int ch0 = u.g * 128 + wc * 32 + 8 * fq;
        f32x4 ba[2], bx[2], nsp[2];
#pragma unroll
        for (int n = 0; n < 2; ++n) { ba[n] = *(const f32x4*)(b_a + ch0 + 4 * n); bx[n] = *(const f32x4*)(b_x + ch0 + 4 * n); const f32x4 l = *(const f32x4*)(lam + ch0 + 4 * n);
#pragma unroll
            for (int j = 0; j < 4; ++j) nsp[n][j] = -8.0f * log1pf(__expf(-l[j])); }
        u32x4 xw[2][4];
#pragma unroll
        for (int ai = 0; ai < 2; ++ai)
#pragma unroll
            for (int m = 0; m < 4; ++m) { const int row = u.pm * BM + ai * HALF + wr * 64 + m * 16 + fr; xw[ai][m] = *(const u32x4*)(A2 + (size_t)row * D + 1024 + ch0); }
#pragma unroll
        for (int ai = 0; ai < 2; ++ai)
#pragma unroll
            for (int m = 0; m < 4; ++m) { const int row = u.pm * BM + ai * HALF + wr * 64 + m * 16 + fr; const bool first = (row & (SEQ - 1)) == 0;
                const float xc[2][4] = {{bf_lo(xw[ai][m].x), bf_hi(xw[ai][m].x), bf_lo(xw[ai][m].y), bf_hi(xw[ai][m].y)}, {bf_lo(xw[ai][m].z), bf_hi(xw[ai][m].z), bf_lo(xw[ai][m].w), bf_hi(xw[ai][m].w)}};
                float dv[2][4], bv[2][4];
#pragma unroll
                for (int n = 0; n < 2; ++n)
#pragma unroll
                    for (int j = 0; j < 4; ++j) {
                        const float r = sigmoidf_(acc[ai][0][m][n][j] + ba[n][j]);
                        const float ig = sigmoidf_(acc[ai][1][m][n][j] + bx[n][j]);
                        const float la = nsp[n][j] * r;
                        const float a = __expf(la);
                        const float mult = first ? 1.0f : sqrtf(fmaxf(1.0f - a * a, 0.f));
                        dv[n][j] = 1.0f - a; bv[n][j] = mult * ig * xc[n][j]; }
                u32x4 dw, bw;
                dw.x = pk_f16(dv[0][0], dv[0][1]); dw.y = pk_f16(dv[0][2], dv[0][3]); dw.z = pk_f16(dv[1][0], dv[1][1]); dw.w = pk_f16(dv[1][2], dv[1][3]);
                bw.x = pk_f16(bv[0][0], bv[0][1]); bw.y = pk_f16(bv[0][2], bv[0][3]); bw.z = pk_f16(bv[1][0], bv[1][1]); bw.w = pk_f16(bv[1][2], bv[1][3]);
                *(u32x4*)(AH + (size_t)row * 1024 + ch0) = dw; *(u32x4*)(BH + (size_t)row * 1024 + ch0) = bw; }
    }
};
struct EpiSoftmax {
    static constexpr bool PERM = true;
    bf16_t* P; float scale_log2e;
    __device__ __forceinline__ void operator()(f32x4 (&acc)[2][2][4][2], const Unit& u, int wr, int wc, int fr, int fq, LAS unsigned char* lds) const {
        LAS f32x2* X = (LAS f32x2*)(lds + LDS_X);
        float mxs[2][4];
#pragma unroll
        for (int ai = 0; ai < 2; ++ai)
#pragma unroll
            for (int m = 0; m < 4; ++m) {
                float mx = -3.0e38f;
#pragma unroll
                for (int bj = 0; bj < 2; ++bj)
#pragma unroll
                    for (int n = 0; n < 2; ++n) { acc[ai][bj][m][n] = acc[ai][bj][m][n] * scale_log2e; const f32x4 x = acc[ai][bj][m][n]; mx = fmaxf(mx, fmaxf(fmaxf(x[0], x[1]), fmaxf(x[2], x[3]))); }
                mx = fmaxf(mx, __shfl_xor(mx, 16)); mx = fmaxf(mx, __shfl_xor(mx, 32));
                float s = 0.f;
#pragma unroll
                for (int bj = 0; bj < 2; ++bj)
#pragma unroll
                    for (int n = 0; n < 2; ++n) { f32x4 x = acc[ai][bj][m][n];
#pragma unroll
                        for (int j = 0; j < 4; ++j) { x[j] = __builtin_amdgcn_exp2f(x[j] - mx); s += x[j]; }
                        acc[ai][bj][m][n] = x; }
                s += __shfl_xor(s, 16); s += __shfl_xor(s, 32);
                mxs[ai][m] = mx;
                if (fq == 0) X[(ai * HALF + wr * 64 + m * 16 + fr) * 4 + wc] = (f32x2){mx, s};
            }
        asm volatile("s_waitcnt lgkmcnt(0)" ::: "memory"); __builtin_amdgcn_s_barrier(); asm volatile("" ::: "memory");
        bf16_t* base = P + ((size_t)u.g * SEQ + (size_t)u.pm * BM + wr * 64 + fr) * 256 + wc * 32 + 8 * fq;
#pragma unroll
        for (int ai = 0; ai < 2; ++ai)
#pragma unroll
            for (int m = 0; m < 4; ++m) { const int r = ai * HALF + wr * 64 + m * 16 + fr;
                const f32x2 p0 = X[r * 4 + 0], p1 = X[r * 4 + 1], p2 = X[r * 4 + 2], p3 = X[r * 4 + 3];
                const float M = fmaxf(fmaxf(p0.x, p1.x), fmaxf(p2.x, p3.x));
                const float tot = p0.y * __builtin_amdgcn_exp2f(p0.x - M) + p1.y * __builtin_amdgcn_exp2f(p1.x - M) + p2.y * __builtin_amdgcn_exp2f(p2.x - M) + p3.y * __builtin_amdgcn_exp2f(p3.x - M);
                const float f = __builtin_amdgcn_exp2f(mxs[ai][m] - M) / tot;
                bf16_t* rowp = base + (size_t)(ai * HALF + m * 16) * 256;
#pragma unroll
                for (int bj = 0; bj < 2; ++bj) { const f32x4 v0 = acc[ai][bj][m][0] * f, v1 = acc[ai][bj][m][1] * f;
                    u32x4 w; w.x = cvt_pk_bf16(v0[0], v0[1]); w.y = cvt_pk_bf16(v0[2], v0[3]); w.z = cvt_pk_bf16(v1[0], v1[1]); w.w = cvt_pk_bf16(v1[2], v1[3]);
                    *(u32x4*)(rowp + bj * HALF) = w; } }
    }
};

template <class Epi, class Sched, bool ALIGN_EPI, bool SP2>
__device__ __forceinline__ void gemm_phase(LAS unsigned char* lds, const int K_, const Sched& S, const Epi& E) {
    int K = K_; asm volatile("" : "+s"(K));
    int tid_ = threadIdx.x; asm volatile("" : "+v"(tid_));
    const int tid = tid_, wid = __builtin_amdgcn_readfirstlane(tid >> 6), lane = tid & 63, wr = wid >> 2, wc = wid & 3, fr = lane & 15, fq = lane >> 4;
    const int nt = K / BK;
    unsigned voffA[2], voffB[2];
#pragma unroll
    for (int i = 0; i < 2; ++i) { int R, C; stage_rc(tid * 16 + i * 8192, R, C); const int Rb = Epi::PERM ? ((R & ~31) + perm32(R & 31)) : R;
        voffA[i] = (unsigned)(R * S.lda + C) * 2u; voffB[i] = (unsigned)(Rb * S.ldb + C) * 2u; }
    const size_t kstep = (size_t)(BK * 2);
    const size_t hstepA = (size_t)HALF * S.lda * 2, hstepB = (size_t)HALF * S.ldb * 2;
    const unsigned ldsw = (unsigned)wid * 1024u;
    const int aoff = lds_byte(wr * 64 + fr, fq * 8), boff = lds_byte(wc * 32 + fr, fq * 8);
#define PG8_SA(b, h) (((b) * 2 + (h)) * HTB)
#define PG8_SB(b, h) ((4 + (b) * 2 + (h)) * HTB)
#define PG8_STAGE(bufoff, gbase, voff) do { _Pragma("unroll") for (int _i = 0; _i < 2; ++_i) \
        __builtin_amdgcn_global_load_lds((const unsigned*)((const char*)(gbase) + (voff)[_i]), (LAS unsigned*)(lds + (bufoff) + ldsw + _i * 8192), 16, 0, 0); } while (0)
#define PG8_LDA(dst, b, h) do { _Pragma("unroll") for (int m = 0; m < 4; ++m) _Pragma("unroll") for (int k = 0; k < 2; ++k) dst[m][k] = *(const LAS bf16x8*)(lds + PG8_SA(b, h) + aoff + m * 2048 + k * 1024); } while (0)
#define PG8_LDB(dst, b, h) do { _Pragma("unroll") for (int n = 0; n < 2; ++n) _Pragma("unroll") for (int k = 0; k < 2; ++k) dst[n][k] = *(const LAS bf16x8*)(lds + PG8_SB(b, h) + boff + n * 2048 + k * 1024); } while (0)
#define PG8_MMA(ai, bj, At, Bt) do { __builtin_amdgcn_s_setprio(1); _Pragma("unroll") for (int m = 0; m < 4; ++m) _Pragma("unroll") for (int n = 0; n < 2; ++n) _Pragma("unroll") for (int k = 0; k < 2; ++k) \
        acc[ai][bj][m][n] = __builtin_amdgcn_mfma_f32_16x16x32_bf16(Bt[n][k], At[m][k], acc[ai][bj][m][n], 0, 0, 0); __builtin_amdgcn_s_setprio(0); } while (0)
#define PG8_WAIT_V(n) asm volatile("s_waitcnt vmcnt(" #n ")" ::: "memory")
#define PG8_WAIT_L(n) asm volatile("s_waitcnt lgkmcnt(" #n ")" ::: "memory")
#define PG8_BAR __builtin_amdgcn_s_barrier()
#define PG8_SCHED __builtin_amdgcn_sched_barrier(0)
    Unit cur, nxt; int ui = 0;
    if (!S.next(0, cur)) return;
    f32x4 acc[2][2][4][2];
#pragma unroll
    for (int a = 0; a < 2; ++a)
#pragma unroll
        for (int b = 0; b < 2; ++b)
#pragma unroll
            for (int m = 0; m < 4; ++m)
#pragma unroll
                for (int n = 0; n < 2; ++n) acc[a][b][m][n] = (f32x4){0.f, 0.f, 0.f, 0.f};
    bf16x8 At[4][2], B0[2][2], B1[2][2];
    const char* cA = S.a_ptr(cur); const char* cB = S.b_ptr(cur);
    if constexpr (SP2) {
        PG8_STAGE(PG8_SB(0, 0), cB, voffB); PG8_STAGE(PG8_SB(0, 1), cB + hstepB, voffB); PG8_STAGE(PG8_SA(0, 0), cA, voffA); PG8_STAGE(PG8_SA(0, 1), cA + hstepA, voffA);
        if (wr == 1) PG8_BAR;
        PG8_WAIT_V(2); PG8_BAR;
        PG8_STAGE(PG8_SB(1, 0), cB + kstep, voffB); PG8_STAGE(PG8_SA(1, 0), cA + kstep, voffA); PG8_STAGE(PG8_SB(1, 1), cB + hstepB + kstep, voffB);
        PG8_WAIT_V(6); PG8_BAR;
    } else {
        PG8_STAGE(PG8_SB(0, 0), cB, voffB); PG8_STAGE(PG8_SA(0, 0), cA, voffA); PG8_STAGE(PG8_SB(0, 1), cB + hstepB, voffB); PG8_STAGE(PG8_SA(0, 1), cA + hstepA, voffA);
        if (wr == 1) PG8_BAR;
        PG8_WAIT_V(4); PG8_BAR;
        PG8_STAGE(PG8_SB(1, 0), cB + kstep, voffB); PG8_STAGE(PG8_SA(1, 0), cA + kstep, voffA); PG8_STAGE(PG8_SB(1, 1), cB + hstepB + kstep, voffB);
        PG8_WAIT_V(6); PG8_BAR;
    }
    for (;;) {
        const bool has_next = S.next(ui + 1, nxt);
        const char* nA = has_next ? S.a_ptr(nxt) : cA; const char* nB = has_next ? S.b_ptr(nxt) : cB;
        for (int t = 0; t < nt; t += 2) {
            const bool last = (t == nt - 2);
            const char* a1 = cA + (size_t)(t + 1) * kstep;
            const char* a2 = last ? nA : cA + (size_t)(t + 2) * kstep; const char* b2 = last ? nB : cB + (size_t)(t + 2) * kstep;
            const char* a3 = a2 + kstep; const char* b3 = b2 + kstep;
            if constexpr (SP2) {
            PG8_LDB(B0, 0, 0); PG8_LDB(B1, 0, 1); PG8_SCHED; PG8_LDA(At, 0, 0); PG8_STAGE(PG8_SA(1, 1), a1 + hstepA, voffA);
            PG8_WAIT_V(8); PG8_WAIT_L(0); PG8_BAR; PG8_MMA(0, 0, At, B0); PG8_MMA(0, 1, At, B1); PG8_BAR; PG8_SCHED;
            PG8_LDA(At, 0, 1); PG8_STAGE(PG8_SB(0, 0), b2, voffB); PG8_STAGE(PG8_SB(0, 1), b2 + hstepB, voffB); PG8_STAGE(PG8_SA(0, 0), a2, voffA);
            PG8_WAIT_V(8); PG8_WAIT_L(0); PG8_BAR; PG8_MMA(1, 0, At, B0); PG8_MMA(1, 1, At, B1); PG8_BAR; PG8_SCHED;
            PG8_LDB(B0, 1, 0); PG8_LDB(B1, 1, 1); PG8_SCHED; PG8_LDA(At, 1, 0); PG8_STAGE(PG8_SA(0, 1), a2 + hstepA, voffA);
            PG8_WAIT_V(8); PG8_WAIT_L(0); PG8_BAR; PG8_MMA(0, 0, At, B0); PG8_MMA(0, 1, At, B1); PG8_BAR; PG8_SCHED;
            PG8_LDA(At, 1, 1); PG8_STAGE(PG8_SB(1, 0), b3, voffB); PG8_STAGE(PG8_SB(1, 1), b3 + hstepB, voffB); PG8_STAGE(PG8_SA(1, 0), a3, voffA);
            PG8_WAIT_V(8); PG8_WAIT_L(0); PG8_BAR; PG8_MMA(1, 0, At, B0); PG8_MMA(1, 1, At, B1); PG8_BAR; PG8_SCHED;
            } else {
            PG8_LDB(B0, 0, 0); PG8_SCHED; PG8_LDA(At, 0, 0); PG8_STAGE(PG8_SA(1, 1), a1 + hstepA, voffA);
            PG8_WAIT_L(8); PG8_BAR; PG8_WAIT_L(0); PG8_MMA(0, 0, At, B0); PG8_BAR; PG8_SCHED;
            PG8_LDB(B1, 0, 1); PG8_STAGE(PG8_SB(0, 0), b2, voffB);
            PG8_BAR; PG8_WAIT_L(0); PG8_MMA(0, 1, At, B1); PG8_BAR;
            PG8_LDA(At, 0, 1); PG8_STAGE(PG8_SA(0, 0), a2, voffA);
            PG8_BAR; PG8_WAIT_L(0); PG8_MMA(1, 0, At, B0); PG8_BAR; PG8_SCHED;
            PG8_STAGE(PG8_SB(0, 1), b2 + hstepB, voffB);
            PG8_WAIT_V(6); PG8_BAR; PG8_MMA(1, 1, At, B1); PG8_BAR;
            PG8_LDB(B0, 1, 0); PG8_SCHED; PG8_LDA(At, 1, 0); PG8_STAGE(PG8_SA(0, 1), a2 + hstepA, voffA);
            PG8_WAIT_L(8); PG8_BAR; PG8_WAIT_L(0); PG8_MMA(0, 0, At, B0); PG8_BAR; PG8_SCHED;
            PG8_LDB(B1, 1, 1); PG8_STAGE(PG8_SB(1, 0), b3, voffB);
            PG8_BAR; PG8_WAIT_L(0); PG8_MMA(0, 1, At, B1); PG8_BAR;
            PG8_LDA(At, 1, 1); PG8_STAGE(PG8_SA(1, 0), a3, voffA);
            PG8_BAR; PG8_WAIT_L(0); PG8_MMA(1, 0, At, B0); PG8_BAR; PG8_SCHED;
            PG8_STAGE(PG8_SB(1, 1), b3 + hstepB, voffB);
            PG8_WAIT_V(6); PG8_BAR; PG8_MMA(1, 1, At, B1); PG8_BAR;
            }
        }
        if constexpr (ALIGN_EPI) { if (wr == 0) PG8_BAR; }
        E(acc, cur, wr, wc, fr, fq, lds);
        if (!has_next) break;
#pragma unroll
        for (int a = 0; a < 2; ++a)
#pragma unroll
            for (int b = 0; b < 2; ++b)
#pragma unroll
                for (int m = 0; m < 4; ++m)
#pragma unroll
                    for (int n = 0; n < 2; ++n) acc[a][b][m][n] = (f32x4){0.f, 0.f, 0.f, 0.f};
        cur = nxt; cA = nA; cB = nB; ++ui;
        if constexpr (ALIGN_EPI) { if (wr == 1) PG8_BAR; }
    }
    PG8_WAIT_V(0);
    if constexpr (!ALIGN_EPI) { if (wr == 0) PG8_BAR; }
    PG8_BAR;
#undef PG8_SA
#undef PG8_SB
#undef PG8_STAGE
#undef PG8_LDA
#undef PG8_LDB
#undef PG8_MMA
#undef PG8_WAIT_V
#undef PG8_WAIT_L
#undef PG8_BAR
#undef PG8_SCHED
}
}

#ifndef PG8_SP2
#define PG8_SP2 true
#endif

struct TDesc { const float* W; bf16_t* WT; int K, N, row_off, item; };
__device__ __forceinline__ void p0_item_load(const TDesc& d, f32x4 (&v)[16], int lane) {
    const int nblk = d.N / 64, kb = d.item / nblk, nb = d.item % nblk, k0 = 64 * kb, n0 = 64 * nb;
    const int nn = (lane & 15) * 4;
#pragma unroll
    for (int i = 0; i < 16; ++i) { const int kk = 4 * i + (lane >> 4); v[i] = *(const f32x4*)(d.W + (size_t)(k0 + kk) * d.N + n0 + nn); }
}
__device__ __forceinline__ void p0_item_store(const TDesc& d, const f32x4 (&v)[16], LAS float* scr, int lane) {
    const int nblk = d.N / 64, kb = d.item / nblk, nb = d.item % nblk, k0 = 64 * kb, n0 = 64 * nb;
    const int nn = (lane & 15) * 4;
#pragma unroll
    for (int i = 0; i < 16; ++i) { const int kk = 4 * i + (lane >> 4); LAS float* q = scr + kk * 65 + nn; q[0] = v[i][0]; q[1] = v[i][1]; q[2] = v[i][2]; q[3] = v[i][3]; }
    asm volatile("s_waitcnt lgkmcnt(0)" ::: "memory");
    const int c = lane & 7;
#pragma unroll
    for (int j = 0; j < 8; ++j) { const int n = (lane >> 3) + 8 * j; const LAS float* sp = scr + (8 * c) * 65 + n;
        u32x4 o; o.x = cvt_pk_bf16(sp[0 * 65], sp[1 * 65]); o.y = cvt_pk_bf16(sp[2 * 65], sp[3 * 65]); o.z = cvt_pk_bf16(sp[4 * 65], sp[5 * 65]); o.w = cvt_pk_bf16(sp[6 * 65], sp[7 * 65]);
        *(u32x4*)(d.WT + (size_t)(d.row_off + n0 + n) * d.K + k0 + 8 * c) = o; }
    asm volatile("s_waitcnt lgkmcnt(0)" ::: "memory");
}

template <bool RBF>
__device__ __forceinline__ void ln_rows(const void* Rv, const bf16_t* Y, float* O, const float* g, const float* b, bf16_t* XBo, int gw, int NGW, int lane) {
    for (int row = gw; row < T; row += NGW) {
        const bf16_t* yr = Y + (size_t)row * D + 4 * lane;
        f32x4 v[8]; float s = 0.f;
#pragma unroll
        for (int j = 0; j < 8; ++j) {
            f32x4 r;
            if constexpr (RBF) { const u32x2 rw = *(const u32x2*)((const bf16_t*)Rv + (size_t)row * D + 4 * lane + 256 * j); r[0] = bf_lo(rw.x); r[1] = bf_hi(rw.x); r[2] = bf_lo(rw.y); r[3] = bf_hi(rw.y); }
            else r = *(const f32x4*)((const float*)Rv + (size_t)row * D + 4 * lane + 256 * j);
            const u32x2 y = *(const u32x2*)(yr + 256 * j);
            v[j][0] = r[0] * ALPHA + bf_lo(y.x); v[j][1] = r[1] * ALPHA + bf_hi(y.x); v[j][2] = r[2] * ALPHA + bf_lo(y.y); v[j][3] = r[3] * ALPHA + bf_hi(y.y);
            s += (v[j][0] + v[j][1]) + (v[j][2] + v[j][3]); }
        const float mean = wave_sum(s) * (1.0f / D); float s2 = 0.f;
#pragma unroll
        for (int j = 0; j < 8; ++j) { v[j] = v[j] - mean; s2 += (v[j][0] * v[j][0] + v[j][1] * v[j][1]) + (v[j][2] * v[j][2] + v[j][3] * v[j][3]); }
        const float rstd = 1.0f / sqrtf(wave_sum(s2) * (1.0f / D) + LN_EPS);
#pragma unroll
        for (int j = 0; j < 8; ++j) { const f32x4 g4 = *(const f32x4*)(g + 4 * lane + 256 * j), b4 = *(const f32x4*)(b + 4 * lane + 256 * j);
            const f32x4 y = v[j] * rstd * g4 + b4;
            if (O) *(f32x4*)(O + (size_t)row * D + 4 * lane + 256 * j) = y;
            if (XBo) { u32x2 w; w.x = cvt_pk_bf16(y[0], y[1]); w.y = cvt_pk_bf16(y[2], y[3]); *(u32x2*)(XBo + (size_t)row * D + 4 * lane + 256 * j) = w; } }
    }
}

#define XB_TMO      128
#define XB_XCNT(j)  (256  + 64 * (j))
#define XB_XSUB(j)  (1280 + 64 * (j))
#define XB_XGEN(j)  (2304 + 64 * (j))
#define XB_TOP      3328
#define XB_TOPGEN   3392
#define XCD_BAR_WORDS 3456
#define XB_SPIN_CAP (1u << 18)
__device__ __forceinline__ unsigned xb_ld(unsigned* p)              { return __hip_atomic_load(p, __ATOMIC_RELAXED, __HIP_MEMORY_SCOPE_AGENT); }
__device__ __forceinline__ unsigned xb_add(unsigned* p, unsigned v) { return __hip_atomic_fetch_add(p, v, __ATOMIC_RELAXED, __HIP_MEMORY_SCOPE_AGENT); }
__device__ __forceinline__ unsigned xb_xcc_id() { return (unsigned)__builtin_amdgcn_s_getreg((3 << 11) | 20) & 0xFu; }
#define XB_SPIN(cond, bar) do { unsigned _sp = 0; while (cond) { __builtin_amdgcn_s_sleep(1); \
    if ((++_sp & 255u) == 0u) { if (xb_ld(&(bar)[XB_TMO])) break; if (_sp > XB_SPIN_CAP) { atomicAdd(&(bar)[XB_TMO], 1u); break; } } } } while (0)
struct XcdBarrier { unsigned* bar; unsigned x; volatile LAS unsigned* st; };
__device__ __forceinline__ XcdBarrier xcd_barrier_post(unsigned* bar, volatile LAS unsigned* st) {
    XcdBarrier b; b.bar = bar; b.x = xb_xcc_id(); b.st = st;
    if (threadIdx.x == 0) (void)xb_add(&bar[XB_XCNT(b.x)], 1u);
    return b;
}
__device__ __forceinline__ void xcd_barrier_complete(unsigned* bar, unsigned x, unsigned& nloc, unsigned& nx) {
    const unsigned G = gridDim.x * gridDim.y * gridDim.z;
    unsigned sum, cnt, mine, sp = 0u;
    for (;;) {
        sum = 0u; cnt = 0u; mine = 0u;
#pragma unroll
        for (unsigned j = 0; j < 16; ++j) { const unsigned c = xb_ld(&bar[XB_XCNT(j)]); sum += c; cnt += (c > 0u) ? 1u : 0u; mine = (j == x) ? c : mine; }
        if (sum == G) break;
        __builtin_amdgcn_s_sleep(1);
        if ((++sp & 255u) == 0u) { if (xb_ld(&bar[XB_TMO])) break; if (sp > XB_SPIN_CAP) { atomicAdd(&bar[XB_TMO], 1u); break; } }
    }
    nloc = mine > 0u ? mine : 1u; nx = cnt > 0u ? cnt : 1u;
}
__device__ __forceinline__ void xcd_barrier(const XcdBarrier& b) {
    asm volatile("s_waitcnt vmcnt(0)" ::: "memory");
    __syncthreads();
    if (threadIdx.x == 0) {
        unsigned* bar = b.bar;
        __builtin_amdgcn_s_waitcnt(0);
        unsigned nloc = b.st[0], nx = b.st[1];
        if (nloc == 0u) { xcd_barrier_complete(bar, b.x, nloc, nx); b.st[0] = nloc; b.st[1] = nx; }
        const unsigned old = xb_add(&bar[XB_XSUB(b.x)], 1u);
        const unsigned gen = old / nloc;
        if (old + 1u == (gen + 1u) * nloc) {
            __builtin_amdgcn_fence(__ATOMIC_RELEASE, "agent");
            asm volatile("s_waitcnt vmcnt(0)" ::: "memory");
            const unsigned og = xb_add(&bar[XB_TOP], 1u);
            const unsigned tg = og / nx;
            if (og + 1u == (tg + 1u) * nx) xb_add(&bar[XB_TOPGEN], 1u);
            else XB_SPIN(xb_ld(&bar[XB_TOPGEN]) == tg, bar);
            __builtin_amdgcn_fence(__ATOMIC_ACQUIRE, "agent");
            xb_add(&bar[XB_XGEN(b.x)], 1u);
            asm volatile("s_waitcnt vmcnt(0)" ::: "memory");
        } else {
            XB_SPIN(xb_ld(&bar[XB_XGEN(b.x)]) == gen, bar);
            __builtin_amdgcn_fence(__ATOMIC_ACQUIRE, "agent");
            asm volatile("s_waitcnt vmcnt(0)" ::: "memory");
        }
    }
    __syncthreads();
}

struct Args { const float* in[26]; float* out; unsigned char* ws; int ph_lo, ph_hi; };
constexpr int N_PHASES = 15;

__global__ void __launch_bounds__(512, 2) fwd_mega(Args args) {
    extern __shared__ __attribute__((aligned(16))) unsigned char lds_raw[];
    LAS unsigned char* lds = (LAS unsigned char*)lds_raw;
    const int G = gridDim.x, bid = blockIdx.x;
    const int NGW = G * 8; const long NGT = (long)G * 512;
#define PHASE_IDS() int tid = threadIdx.x; asm volatile("" : "+v"(tid)); const int lane = tid & 63, wave = __builtin_amdgcn_readfirstlane(tid >> 6); \
    const int gw = bid * 8 + wave; const long gt = (long)bid * 512 + tid; (void)lane; (void)gw; (void)gt;
    unsigned char* ws = args.ws;
    const float* x = args.in[0]; const float* mem = args.in[1];
    bf16_t* WIN = (bf16_t*)(ws + WS_WIN); bf16_t* WOUT = (bf16_t*)(ws + WS_WOUT); bf16_t* WQ = (bf16_t*)(ws + WS_WQ); bf16_t* WK = (bf16_t*)(ws + WS_WK);
    bf16_t* WV = (bf16_t*)(ws + WS_WV); bf16_t* WO = (bf16_t*)(ws + WS_WO); bf16_t* WFF1 = (bf16_t*)(ws + WS_WFF1); bf16_t* WFF2 = (bf16_t*)(ws + WS_WFF2);
    bf16_t* WPOOL = (bf16_t*)(ws + WS_WPOOL); bf16_t* WAX = (bf16_t*)(ws + WS_WAX);
    bf16_t* MEMB = (bf16_t*)(ws + WS_MEMB); bf16_t* KB = (bf16_t*)(ws + WS_KB); bf16_t* VT = (bf16_t*)(ws + WS_VT);
    bf16_t* XB = (bf16_t*)(ws + WS_XB); unsigned short* BH = (unsigned short*)(ws + WS_BF); bf16_t* PROJ = (bf16_t*)(ws + WS_PROJ); bf16_t* Y3 = (bf16_t*)(ws + WS_Y3); bf16_t* QB = (bf16_t*)(ws + WS_Q); bf16_t* YB = (bf16_t*)(ws + WS_Q);
    bf16_t* PB = (bf16_t*)(ws + WS_PB); bf16_t* A2 = (bf16_t*)(ws + WS_A2); float* SUMP = (float*)(ws + WS_SUM); float* SUMH = SUMP + 4 * 64 * 1024;
    bf16_t* OB = (bf16_t*)(ws + WS_O); bf16_t* MIX = (bf16_t*)(ws + WS_MIX); unsigned short* AH = (unsigned short*)(ws + WS_AF); bf16_t* HB = (bf16_t*)(ws + WS_H);
    float* out = args.out;
    const int lo = args.ph_lo, hi = args.ph_hi;
#define IN(k) (lo <= (k) && (k) < hi)
#define SEAM(k) do { if (IN(k) && IN((k) + 1)) { xcd_barrier(bar); } } while (0)
    volatile LAS unsigned* bst = (volatile LAS unsigned*)(lds + LDS_BARST);
    if (threadIdx.x < 4) bst[threadIdx.x] = 0u;
    __syncthreads();
    XcdBarrier bar = xcd_barrier_post((unsigned*)(ws + WS_CTL) + 4096, bst);
    if (lo < -1) cg::this_grid().sync();

    if (IN(0)) for (int rep_ = 0; rep_ <= ((PROBE_DUP_MASK >> 0) & 1); ++rep_) {
        PHASE_IDS();
        LAS float* scr = (LAS float*)(lds + wave * 16640);
        constexpr int I_IN = 32 * 48, I_SQ = 32 * 32, I_F1 = 32 * 128, I_F2 = 128 * 32, I_POOL = 4 * 16, I_AX = 16 * 4;
        constexpr int NIT = I_IN + 5 * I_SQ + I_F1 + I_F2 + I_POOL + I_AX;
#define P0_RESOLVE(it_, d_) do { int r = (it_); \
            if (r < I_F1) { d_ = TDesc{args.in[22], WFF1, D, DFF, 0, r}; break; } r -= I_F1; \
            if (r < I_F2) { d_ = TDesc{args.in[23], WFF2, DFF, D, 0, r}; break; } r -= I_F2; \
            if (r < I_IN) { d_ = TDesc{args.in[2], WIN, D, NPROJ, 0, r}; break; } r -= I_IN; \
            if (r < I_SQ) { d_ = TDesc{args.in[13], WOUT, D, D, 0, r}; break; } r -= I_SQ; \
            if (r < I_SQ) { d_ = TDesc{args.in[16], WQ, D, D, 0, r}; break; } r -= I_SQ; \
            if (r < I_SQ) { d_ = TDesc{args.in[17], WK, D, D, 0, r}; break; } r -= I_SQ; \
            if (r < I_SQ) { d_ = TDesc{args.in[18], WV, D, D, 0, r}; break; } r -= I_SQ; \
            if (r < I_SQ) { d_ = TDesc{args.in[19], WO, D, D, 0, r}; break; } r -= I_SQ; \
            if (r < I_POOL) { const int g = r >> 4; d_ = TDesc{args.in[10] + (size_t)g * 65536, WPOOL + (size_t)g * 65536, 256, 256, 0, r & 15}; break; } r -= I_POOL; \
            { const int mtx = r >> 2, h = mtx >> 1, which = mtx & 1;       \
              d_ = TDesc{args.in[which ? 7 : 5] + (size_t)h * 16384, WAX + (size_t)h * 32768, 128, 128, which * 128, r & 3}; } } while (0)
        if (gw < NIT) {
            TDesc dc, dn; f32x4 vc[16], vn[16];
            P0_RESOLVE(gw, dc); p0_item_load(dc, vc, lane);
            for (int it = gw;;) {
                const int itn = it + NGW; const bool has_next = itn < NIT;
                if (has_next) { P0_RESOLVE(itn, dn); p0_item_load(dn, vn, lane); }
                p0_item_store(dc, vc, scr, lane);
                if (!has_next) break;
                dc = dn; it = itn;
#pragma unroll
                for (int i = 0; i < 16; ++i) vc[i] = vn[i];
            }
        }
#undef P0_RESOLVE
#pragma unroll 4
        for (long i = gt; i < (long)T * D / 8; i += NGT) { const f32x4 a = *(const f32x4*)(x + i * 8), b = *(const f32x4*)(x + i * 8 + 4);
            u32x4 w; w.x = cvt_pk_bf16(a[0], a[1]); w.y = cvt_pk_bf16(a[2], a[3]); w.z = cvt_pk_bf16(b[0], b[1]); w.w = cvt_pk_bf16(b[2], b[3]); *(u32x4*)(XB + i * 8) = w; }
        for (long i = gt; i < (long)NMEMROWS * D / 8; i += NGT) { const f32x4 a = *(const f32x4*)(mem + i * 8), b = *(const f32x4*)(mem + i * 8 + 4);
            u32x4 w; w.x = cvt_pk_bf16(a[0], a[1]); w.y = cvt_pk_bf16(a[2], a[3]); w.z = cvt_pk_bf16(b[0], b[1]); w.w = cvt_pk_bf16(b[2], b[3]); *(u32x4*)(MEMB + i * 8) = w; }
        __syncthreads();
    }
    SEAM(0);

    if (IN(1)) for (int rep_ = 0; rep_ <= ((PROBE_DUP_MASK >> 1) & 1); ++rep_) {
        { pg8::GSched S; S.init(XB, D, WIN, D, 1, 64, 12, G, bid); pg8::EpiBf16 E{PROJ, NPROJ, 0, 0, 1, 0};
          pg8::gemm_phase<pg8::EpiBf16, pg8::GSched, true, PG8_SP2>(lds, D, S, E); }
    }
    SEAM(1);

    if (IN(2)) for (int rep_ = 0; rep_ <= ((PROBE_DUP_MASK >> 2) & 1); ++rep_) {
        PHASE_IDS();
        const float* conv_w = args.in[3]; const float* conv_b = args.in[4];
        for (long it = gt; it < (long)(T / 32) * 256; it += NGT) {
            const int chunk = (int)(it & 255), r0 = (int)(it >> 8) * 32, pos0 = r0 & (SEQ - 1);
            if (chunk < 128) {
                const int g = chunk >> 5, w = 2 << g;
                const bf16_t* p = PROJ + (size_t)r0 * NPROJ + chunk * 8;
                float s[8];
#pragma unroll
                for (int j = 0; j < 8; ++j) s[j] = 0.f;
                for (int k = 1; k < w; ++k) { if (pos0 - k >= 0) { const u32x4 v = *(const u32x4*)(p - (size_t)k * NPROJ);
                    s[0] += bf_lo(v.x); s[1] += bf_hi(v.x); s[2] += bf_lo(v.y); s[3] += bf_hi(v.y); s[4] += bf_lo(v.z); s[5] += bf_hi(v.z); s[6] += bf_lo(v.w); s[7] += bf_hi(v.w); } }
#pragma unroll 8
                for (int t = 0; t < 32; ++t) {
                    const int pos = pos0 + t;
                    const u32x4 v = *(const u32x4*)(p + (size_t)t * NPROJ);
                    const float u[8] = {bf_lo(v.x), bf_hi(v.x), bf_lo(v.y), bf_hi(v.y), bf_lo(v.z), bf_hi(v.z), bf_lo(v.w), bf_hi(v.w)};
#pragma unroll
                    for (int j = 0; j < 8; ++j) s[j] += u[j];
                    const int cnt = (pos + 1) < w ? (pos + 1) : w; const float inv = 1.0f / (float)cnt;
                    u32x4 o; o.x = cvt_pk_bf16(s[0] * inv - u[0], s[1] * inv - u[1]); o.y = cvt_pk_bf16(s[2] * inv - u[2], s[3] * inv - u[3]);
                    o.z = cvt_pk_bf16(s[4] * inv - u[4], s[5] * inv - u[5]); o.w = cvt_pk_bf16(s[6] * inv - u[6], s[7] * inv - u[7]);
                    *(u32x4*)(A2 + (size_t)(r0 + t) * D + chunk * 8) = o;
                    if (pos + 1 - w >= 0) { const u32x4 q = *(const u32x4*)(p + ((long)t + 1 - w) * NPROJ);
                        s[0] -= bf_lo(q.x); s[1] -= bf_hi(q.x); s[2] -= bf_lo(q.y); s[3] -= bf_hi(q.y); s[4] -= bf_lo(q.z); s[5] -= bf_hi(q.z); s[6] -= bf_lo(q.w); s[7] -= bf_hi(q.w); }
                }
            } else {
                const int c = (chunk - 128) * 8;
                const bf16_t* p = PROJ + (size_t)r0 * NPROJ + 1024 + c;
                float cw[4][8], cb[8];
#pragma unroll
                for (int k = 0; k < 4; ++k) { const f32x4 w0 = *(const f32x4*)(conv_w + k * 1024 + c), w1 = *(const f32x4*)(conv_w + k * 1024 + c + 4);
                    cw[k][0] = w0[0]; cw[k][1] = w0[1]; cw[k][2] = w0[2]; cw[k][3] = w0[3]; cw[k][4] = w1[0]; cw[k][5] = w1[1]; cw[k][6] = w1[2]; cw[k][7] = w1[3]; }
                { const f32x4 b0 = *(const f32x4*)(conv_b + c), b1 = *(const f32x4*)(conv_b + c + 4); cb[0] = b0[0]; cb[1] = b0[1]; cb[2] = b0[2]; cb[3] = b0[3]; cb[4] = b1[0]; cb[5] = b1[1]; cb[6] = b1[2]; cb[7] = b1[3]; }
                const u32x4 zero = {0u, 0u, 0u, 0u};
                u32x4 v0 = zero, v1 = zero, v2 = zero;
                if (pos0 > 0) { v0 = *(const u32x4*)(p - 3 * (size_t)NPROJ); v1 = *(const u32x4*)(p - 2 * (size_t)NPROJ); v2 = *(const u32x4*)(p - (size_t)NPROJ); }
#pragma unroll 8
                for (int t = 0; t < 32; ++t) {
                    const u32x4 v3 = *(const u32x4*)(p + (size_t)t * NPROJ);
                    float s[8];
#pragma unroll
                    for (int j = 0; j < 8; ++j) s[j] = cb[j];
#define CONV_TAP(k, v) s[0] += cw[k][0] * bf_lo(v.x); s[1] += cw[k][1] * bf_hi(v.x); s[2] += cw[k][2] * bf_lo(v.y); s[3] += cw[k][3] * bf_hi(v.y); \
                       s[4] += cw[k][4] * bf_lo(v.z); s[5] += cw[k][5] * bf_hi(v.z); s[6] += cw[k][6] * bf_lo(v.w); s[7] += cw[k][7] * bf_hi(v.w);
                    CONV_TAP(0, v0) CONV_TAP(1, v1) CONV_TAP(2, v2) CONV_TAP(3, v3)
#undef CONV_TAP
                    u32x4 o; o.x = cvt_pk_bf16(s[0], s[1]); o.y = cvt_pk_bf16(s[2], s[3]); o.z = cvt_pk_bf16(s[4], s[5]); o.w = cvt_pk_bf16(s[6], s[7]);
                    *(u32x4*)(A2 + (size_t)(r0 + t) * D + 1024 + c) = o;
                    v0 = v1; v1 = v2; v2 = v3;
                }
            }
        }
    }
    SEAM(2);

    if (IN(3)) for (int rep_ = 0; rep_ <= ((PROBE_DUP_MASK >> 3) & 1); ++rep_) {
        if (bid < 32) { pg8::GSched S; S.init(MEMB, D, WK, D, 1, 4, 8, 32, bid); pg8::EpiBf16 E{KB, D, 0, 0, 1, 0};
          pg8::gemm_phase<pg8::EpiBf16, pg8::GSched, true, PG8_SP2>(lds, D, S, E); }
        else if (bid < 64) { pg8::GSched S; S.init(WV, D, MEMB, D, 1, 8, 4, 32, bid - 32); pg8::EpiBf16 E{VT, NMEMROWS, 0, 0, 1, 0};
          pg8::gemm_phase<pg8::EpiBf16, pg8::GSched, true, PG8_SP2>(lds, D, S, E); }
        else {
        const int G2 = G - 64, c2 = bid - 64;
        { pg8::GSched S; S.init(A2, D, WPOOL, 256, 4, 64, 1, G2, c2); S.ga1 = 256; S.gb1 = 65536; pg8::EpiPool E{MIX, args.in[11], args.in[12]};
          pg8::gemm_phase<pg8::EpiPool, pg8::GSched, true, PG8_SP2>(lds, 256, S, E); }
        { pg8::GSched S; S.init(A2 + 1024, D, WAX, 128, 8, 64, 1, G2, (c2 + 128) % G2); S.ga1 = 128; S.gb1 = 32768; pg8::EpiLru E{A2, args.in[6], args.in[8], args.in[9], AH, BH};
          pg8::gemm_phase<pg8::EpiLru, pg8::GSched, true, PG8_SP2>(lds, 128, S, E); }
        }
    }
    SEAM(3);

    if (IN(4)) for (int rep_ = 0; rep_ <= ((PROBE_DUP_MASK >> 4) & 1); ++rep_) {
        PHASE_IDS();
        for (int it = (int)gt; it < 4 * 64 * 512; it += (int)NGT) {
            const int c2 = it & 511, k = (it >> 9) & 63, b = it >> 15;
            const size_t o0 = ((size_t)b * SEQ + k * 64) * 1024 + 2 * c2;
            const unsigned short* pa = AH + o0; const unsigned short* pb = BH + o0;
            float h0 = 0.f, h1 = 0.f, P0 = 1.f, P1 = 1.f;
#pragma unroll 8
            for (int t = 0; t < 64; ++t) { const unsigned dw = *(const unsigned*)(pa + (size_t)t * 1024), bw = *(const unsigned*)(pb + (size_t)t * 1024);
                const float a0 = 1.0f - h_lo(dw), a1 = 1.0f - h_hi(dw); h0 = a0 * h0 + h_lo(bw); h1 = a1 * h1 + h_hi(bw); P0 *= a0; P1 *= a1; }
            *(f32x2*)(SUMP + (size_t)(b * 64 + k) * 1024 + 2 * c2) = (f32x2){P0, P1}; *(f32x2*)(SUMH + (size_t)(b * 64 + k) * 1024 + 2 * c2) = (f32x2){h0, h1};
        }
    }
    SEAM(4);

    if (IN(5)) for (int rep_ = 0; rep_ <= ((PROBE_DUP_MASK >> 5) & 1); ++rep_) {
        PHASE_IDS();
        for (int it = (int)gt; it < 4 * 64 * 512; it += (int)NGT) {
            const int c2 = it & 511, k = (it >> 9) & 63, b = it >> 15;
            const float* sp = SUMP + (size_t)b * 65536 + 2 * c2; const float* sh = SUMH + (size_t)b * 65536 + 2 * c2;
            float h0 = 0.f, h1 = 0.f;
#pragma unroll 8
            for (int kk = 0; kk < k; ++kk) { const f32x2 p = *(const f32x2*)(sp + kk * 1024), q = *(const f32x2*)(sh + kk * 1024); h0 = h0 * p.x + q.x; h1 = h1 * p.y + q.y; }
            const size_t r0 = (size_t)b * SEQ + k * 64;
            const unsigned short* pa = AH + r0 * 1024 + 2 * c2; const unsigned short* pb = BH + r0 * 1024 + 2 * c2;
            const bf16_t* pg = PROJ + r0 * NPROJ + 2048 + 2 * c2; bf16_t* po = MIX + r0 * D + 1024 + 2 * c2;
#pragma unroll 8
            for (int t = 0; t < 64; ++t) { const unsigned dw = *(const unsigned*)(pa + (size_t)t * 1024), bw = *(const unsigned*)(pb + (size_t)t * 1024), gw2 = *(const unsigned*)(pg + (size_t)t * NPROJ);
                h0 = (1.0f - h_lo(dw)) * h0 + h_lo(bw); h1 = (1.0f - h_hi(dw)) * h1 + h_hi(bw);
                *(unsigned*)(po + (size_t)t * D) = cvt_pk_bf16(h0 * gelu_tanh(bf_lo(gw2)), h1 * gelu_tanh(bf_hi(gw2))); }
        }
    }
    SEAM(5);

    if (IN(6)) for (int rep_ = 0; rep_ <= ((PROBE_DUP_MASK >> 6) & 1); ++rep_) {
        pg8::GSched S; S.init(MIX, D, WOUT, D, 1, 64, 8, G, bid); pg8::EpiBf16 E{YB, D, 0, 0, 1, 0};
        pg8::gemm_phase<pg8::EpiBf16, pg8::GSched, true, PG8_SP2>(lds, D, S, E);
    }
    SEAM(6);
    if (IN(7)) for (int rep_ = 0; rep_ <= ((PROBE_DUP_MASK >> 7) & 1); ++rep_) { PHASE_IDS(); ln_rows<false>(x, YB, nullptr, args.in[14], args.in[15], XB, gw, NGW, lane); }
    SEAM(7);
    if (IN(8)) for (int rep_ = 0; rep_ <= ((PROBE_DUP_MASK >> 8) & 1); ++rep_) {
        pg8::GSched S; S.init(XB, D, WQ, D, 1, 64, 8, G, bid); pg8::EpiBf16 E{QB, D, 0, 0, 1, 0};
        pg8::gemm_phase<pg8::EpiBf16, pg8::GSched, true, PG8_SP2>(lds, D, S, E);
    }
    SEAM(8);
    if (IN(9)) for (int rep_ = 0; rep_ <= ((PROBE_DUP_MASK >> 9) & 1); ++rep_) {
        pg8::GSched S; S.init(QB, D, KB, D, 16, 16, 1, G, bid); S.gdiv = 4; S.ga1 = (long)SEQ * D; S.ga0 = 512; S.gb1 = 256L * D; S.gb0 = 512;
        pg8::EpiSoftmax E{PB, 0.04419417382415922f * 1.4426950408889634f};
        pg8::gemm_phase<pg8::EpiSoftmax, pg8::GSched, true, PG8_SP2>(lds, 512, S, E);
    }
    SEAM(9);
    if (IN(10)) for (int rep_ = 0; rep_ <= ((PROBE_DUP_MASK >> 10) & 1); ++rep_) {
        pg8::GSched S; S.init(PB, 256, VT, NMEMROWS, 16, 16, 2, G, bid); S.gdiv = 4; S.ga1 = 4L * SEQ * 256; S.ga0 = (long)SEQ * 256; S.gb1 = 256; S.gb0 = 512L * NMEMROWS;
        pg8::EpiBf16 E{OB, D, (long)SEQ * D, 512, 4, 0};
        pg8::gemm_phase<pg8::EpiBf16, pg8::GSched, true, PG8_SP2>(lds, 256, S, E);
    }
    SEAM(10);
    if (IN(11)) for (int rep_ = 0; rep_ <= ((PROBE_DUP_MASK >> 11) & 1); ++rep_) {
        pg8::GSched S; S.init(OB, D, WO, D, 1, 64, 8, G, bid); pg8::EpiBf16 E{YB, D, 0, 0, 1, 0};
        pg8::gemm_phase<pg8::EpiBf16, pg8::GSched, true, PG8_SP2>(lds, D, S, E);
    }
    SEAM(11);
    if (IN(12)) for (int rep_ = 0; rep_ <= ((PROBE_DUP_MASK >> 12) & 1); ++rep_) { PHASE_IDS(); ln_rows<true>(XB, YB, nullptr, args.in[20], args.in[21], XB, gw, NGW, lane); }
    SEAM(12);
    constexpr size_t CH_ROWS = T / 2;
    if (IN(13)) {
        { pg8::GSched S; S.init(XB, D, WFF1, D, 1, 32, 32, G, bid); pg8::EpiBf16 E{HB, DFF, 0, 0, 1, 1};
          pg8::gemm_phase<pg8::EpiBf16, pg8::GSched, true, PG8_SP2>(lds, D, S, E); }
        xcd_barrier(bar);
        { pg8::GSched S; S.init(HB, DFF, WFF2, DFF, 1, 32, 8, G, bid); pg8::EpiBf16 E{Y3, D, 0, 0, 1, 0};
          pg8::gemm_phase<pg8::EpiBf16, pg8::GSched, true, PG8_SP2>(lds, DFF, S, E); }
        { pg8::GSched S; S.init(XB + CH_ROWS * D, D, WFF1, D, 1, 32, 32, G, bid); pg8::EpiBf16 E{HB + CH_ROWS * DFF, DFF, 0, 0, 1, 1};
          pg8::gemm_phase<pg8::EpiBf16, pg8::GSched, true, PG8_SP2>(lds, D, S, E); }
    }
    SEAM(13);
    if (IN(14)) {
        pg8::GSched S; S.init(HB + CH_ROWS * DFF, DFF, WFF2, DFF, 1, 32, 8, G, bid); pg8::EpiBf16 E{Y3 + CH_ROWS * D, D, 0, 0, 1, 0};
        pg8::gemm_phase<pg8::EpiBf16, pg8::GSched, true, PG8_SP2>(lds, DFF, S, E);
    }
    SEAM(14);
    if (IN(15)) for (int rep_ = 0; rep_ <= ((PROBE_DUP_MASK >> 15) & 1); ++rep_) { PHASE_IDS(); ln_rows<true>(XB, Y3, out, args.in[24], args.in[25], nullptr, gw, NGW, lane); }
#undef IN
#undef SEAM
}

extern "C" void kernel_launch(void* const* d_in, const int* in_sizes, int n_in, void* d_out, int out_size, void* d_ws, size_t ws_size, hipStream_t stream) {
    static int grid = 0;
    if (grid == 0) {
        if (n_in != 26 || out_size != T * D || ws_size < WS_END) { fprintf(stderr, "kernel_launch: unexpected shapes (n_in %d out %d ws %zu)\n", n_in, out_size, ws_size); grid = -1; return; }
        int dev = 0, cus = 0, per_cu = 0;
        (void)hipGetDevice(&dev);
        (void)hipDeviceGetAttribute(&cus, hipDeviceAttributeMultiprocessorCount, dev);
        if (hipFuncSetAttribute((const void*)fwd_mega, hipFuncAttributeMaxDynamicSharedMemorySize, LDS_BYTES) != hipSuccess) { fprintf(stderr, "kernel_launch: hipFuncSetAttribute failed\n"); grid = -1; return; }
        if (hipOccupancyMaxActiveBlocksPerMultiprocessor(&per_cu, (const void*)fwd_mega, 512, LDS_BYTES) != hipSuccess || per_cu < 1) { fprintf(stderr, "kernel_launch: occupancy query says %d\n", per_cu); grid = -1; return; }
        grid = cus;
        if (grid % 8 != 0 || grid > 1024) { fprintf(stderr, "kernel_launch: unexpected CU count %d\n", cus); }
    }
    if (grid < 0) return;
    if (hipMemsetAsync((char*)d_ws + WS_CTL, 0, 64 * 1024, stream) != hipSuccess) { fprintf(stderr, "kernel_launch: memset failed\n"); return; }
    Args a{};
    for (int i = 0; i < 26; ++i) a.in[i] = (const float*)d_in[i];
    a.out = (float*)d_out; a.ws = (unsigned char*)d_ws;
#if MK_N_LAUNCHES == 1
#if PROBE_PREFIX >= 0
    { a.ph_lo = 0; a.ph_hi = PROBE_PREFIX + 1; void* kargs0[] = {&a};
      (void)hipLaunchCooperativeKernel((const void*)fwd_mega, dim3(grid), dim3(512), kargs0, LDS_BYTES, stream);
      (void)hipMemsetAsync((char*)d_ws + WS_CTL, 0, 64 * 1024, stream); }
#endif
    a.ph_lo = 0; a.ph_hi = N_PHASES + 1;
    void* kargs[] = {&a};
    hipError_t e = hipLaunchCooperativeKernel((const void*)fwd_mega, dim3(grid), dim3(512), kargs, LDS_BYTES, stream);
    if (e != hipSuccess) fprintf(stderr, "kernel_launch: cooperative launch failed: %s (grid %d)\n", hipGetErrorString(e), grid);
#else
    for (int p = 0; p <= N_PHASES; ++p) { a.ph_lo = p; a.ph_hi = p + 1; hipLaunchKernelGGL(fwd_mega, dim3(grid), dim3(512), LDS_BYTES, stream, a); }
#endif
}
```

```cpp
#include <hip/hip_runtime.h>
#include <hip/hip_cooperative_groups.h>
#include <cstdio>
#include <cstdint>
namespace cg = cooperative_groups;

#ifndef PROBE_DUP_MASK
#define PROBE_DUP_MASK 0
#endif
#ifndef PROBE_LN
#define PROBE_LN 0
#endif
#ifndef PROBE_PREFIX
#define PROBE_PREFIX -1
#endif
#ifndef MK_N_LAUNCHES
#define MK_N_LAUNCHES 1
#endif

#define LAS __attribute__((address_space(3)))
typedef unsigned short bf16_t;
typedef short bf16x8 __attribute__((ext_vector_type(8)));
typedef float f32x4 __attribute__((ext_vector_type(4)));
typedef float f32x2 __attribute__((ext_vector_type(2)));
typedef unsigned u32x4 __attribute__((ext_vector_type(4)));
typedef unsigned u32x2 __attribute__((ext_vector_type(2)));
typedef _Float16 f16x2 __attribute__((ext_vector_type(2)));

constexpr int T = 16384, SEQ = 4096, D = 2048, NPROJ = 3072, DFF = 8192, NMEMROWS = 1024;
constexpr float LN_EPS = 1e-5f;
constexpr float ALPHA = 1.189207115002721f;

constexpr size_t MiB = 1u << 20;
constexpr size_t WS_CTL = 0, CTL_BYTES = 1 * MiB;
constexpr size_t WS_WFF1 = 2 * MiB, WS_WFF2 = 34 * MiB, WS_WIN = 66 * MiB, WS_WOUT = 78 * MiB, WS_WQ = 86 * MiB, WS_WK = 94 * MiB, WS_WV = 102 * MiB, WS_WO = 110 * MiB;
constexpr size_t WS_Y3 = 66 * MiB;
constexpr size_t WS_WPOOL = 118 * MiB, WS_WAX = 118 * MiB + 512 * 1024;
constexpr size_t WS_MEMB = 119 * MiB, WS_KB = 123 * MiB, WS_VT = 127 * MiB;
constexpr size_t WS_XB = 131 * MiB;
constexpr size_t WS_BF = 131 * MiB;
constexpr size_t WS_PROJ = 195 * MiB;
constexpr size_t WS_Q = 195 * MiB;
constexpr size_t WS_PB = 259 * MiB;
constexpr size_t WS_A2 = 291 * MiB;
constexpr size_t WS_SUM = 291 * MiB;
constexpr size_t WS_O = 291 * MiB;
constexpr size_t WS_MIX = 355 * MiB;
constexpr size_t WS_AF = 419 * MiB;
constexpr size_t WS_H = 195 * MiB;
constexpr size_t WS_END = 483 * MiB;

constexpr int LDS_BYTES = 147456;
constexpr int LDS_X = 131072;
constexpr int LDS_BARST = 131072 + 8192;

__device__ __forceinline__ unsigned cvt_pk_bf16(float lo, float hi) { unsigned r; asm volatile("v_cvt_pk_bf16_f32 %0, %1, %2" : "=v"(r) : "v"(lo), "v"(hi)); return r; }
__device__ __forceinline__ float bf_lo(unsigned w) { return __uint_as_float(w << 16); }
__device__ __forceinline__ float bf_hi(unsigned w) { return __uint_as_float(w & 0xffff0000u); }
__device__ __forceinline__ float bf2f(bf16_t b) { return __uint_as_float(((unsigned)b) << 16); }
__device__ __forceinline__ bf16_t f2bf(float f) { unsigned u = __float_as_uint(f); return (bf16_t)((u + 0x7fffu + ((u >> 16) & 1u)) >> 16); }
__device__ __forceinline__ float wave_sum(float v) {
#pragma unroll
    for (int o = 1; o < 64; o <<= 1) v += __shfl_xor(v, o);
    return v;
}
__device__ __forceinline__ unsigned pk_f16(float lo, float hi) { f16x2 v; v.x = (_Float16)lo; v.y = (_Float16)hi; return __builtin_bit_cast(unsigned, v); }
__device__ __forceinline__ float h_lo(unsigned w) { return (float)__builtin_bit_cast(f16x2, w).x; }
__device__ __forceinline__ float h_hi(unsigned w) { return (float)__builtin_bit_cast(f16x2, w).y; }
__device__ __forceinline__ float sigmoidf_(float x) { return 1.0f / (1.0f + __expf(-x)); }
__device__ __forceinline__ float gelu_tanh(float x) {
    const float z = 0.7978845608028654f * (x + 0.044715f * x * x * x);
    const float e = __expf(2.0f * z);
    const float th = 1.0f - 2.0f / (e + 1.0f);
    return 0.5f * x * (1.0f + th);
}

namespace pg8 {
constexpr int BM = 256, BK = 64, HALF = 128, HTB = HALF * BK * 2, STAGE_BYTES = 8 * HTB, NXCD = 8, WGM = 8;
__host__ __device__ __forceinline__ int lds_byte(int r, int c) { const int st = (r >> 4) * 2 + (c >> 5), rr = r & 15, cc = c & 31, ob = rr * 64 + cc * 2; return st * 1024 + (ob ^ (((ob >> 9) & 1) << 5)); }
__host__ __device__ __forceinline__ void stage_rc(int b, int& R, int& C) { const int st = b / 1024, sb = b % 1024, swz = sb ^ (((sb >> 9) & 1) << 5); R = (st >> 1) * 16 + swz / 64; C = (st & 1) * 32 + (swz % 64) / 2; }
__host__ __device__ __forceinline__ int perm32(int rho) { const int n = rho >> 4, i = rho & 15; return 8 * (i >> 2) + 4 * n + (i & 3); }

struct Unit { int pm, pn, g; };

struct GSched {
    const bf16_t* A; const bf16_t* Bt;
    long ga1, ga0, gb1, gb0; int gdiv;
    int lda, ldb, nMg, nVM, nN, nwg, G, c;
    __device__ __forceinline__ void init(const bf16_t* A_, int lda_, const bf16_t* Bt_, int ldb_, int nG, int nMg_, int nN_, int G_, int c_) {
        A = A_; Bt = Bt_; lda = lda_; ldb = ldb_; nMg = nMg_; nVM = nG * nMg_; nN = nN_; nwg = nVM * nN_; G = G_; c = c_;
        ga1 = ga0 = gb1 = gb0 = 0; gdiv = 1;
    }
    __device__ __forceinline__ bool next(int i, Unit& u) const {
        const long L = (long)i * G + c; if (L >= nwg) return false;
        int wgid = (int)L; { const int q = nwg / NXCD, r = nwg % NXCD, xcd = wgid % NXCD, off = wgid / NXCD; wgid = (xcd < r ? xcd * (q + 1) : r * (q + 1) + (xcd - r) * q) + off; }
        const int nig = WGM * nN, gid = wgid / nig, fm = gid * WGM, gsz = (nVM - fm) < WGM ? (nVM - fm) : WGM;
        const int vm = fm + ((wgid % nig) % gsz); u.pn = (wgid % nig) / gsz; u.g = vm / nMg; u.pm = vm % nMg; return true;
    }
    __device__ __forceinline__ const char* a_ptr(const Unit& u) const { return (const char*)(A + (long)(u.g / gdiv) * ga1 + (long)(u.g % gdiv) * ga0 + (long)u.pm * BM * lda); }
    __device__ __forceinline__ const char* b_ptr(const Unit& u) const { return (const char*)(Bt + (long)(u.g / gdiv) * gb1 + (long)(u.g % gdiv) * gb0 + (long)u.pn * BM * ldb); }
};

struct EpiBf16 {
    static constexpr bool PERM = true;
    bf16_t* O; int ldc; long go1, go0; int gdiv; int act;
    __device__ __forceinline__ void operator()(f32x4 (&acc)[2][2][4][2], const Unit& u, int wr, int wc, int fr, int fq, LAS unsigned char*) const {
        bf16_t* base = O + (long)(u.g / gdiv) * go1 + (long)(u.g % gdiv) * go0 + ((size_t)u.pm * BM + wr * 64 + fr) * ldc + u.pn * BM + wc * 32 + 8 * fq;
#pragma unroll
        for (int ai = 0; ai < 2; ++ai)
#pragma unroll
            for (int m = 0; m < 4; ++m) { bf16_t* rowp = base + (size_t)(ai * HALF + m * 16) * ldc;
#pragma unroll
                for (int bj = 0; bj < 2; ++bj) { f32x4 v0 = acc[ai][bj][m][0], v1 = acc[ai][bj][m][1];
                    if (act == 1) {
#pragma unroll
                        for (int j = 0; j < 4; ++j) { const float a0 = fmaxf(v0[j], 0.f), a1 = fmaxf(v1[j], 0.f); v0[j] = a0 * a0; v1[j] = a1 * a1; } }
                    u32x4 w; w.x = cvt_pk_bf16(v0[0], v0[1]); w.y = cvt_pk_bf16(v0[2], v0[3]); w.z = cvt_pk_bf16(v1[0], v1[1]); w.w = cvt_pk_bf16(v1[2], v1[3]);
                    *(u32x4*)(rowp + bj * HALF) = w; } }
    }
};
struct EpiPool {
    static constexpr bool PERM = true;
    bf16_t* O; const float* bias; const float* scale;
    __device__ __forceinline__ void operator()(f32x4 (&acc)[2][2][4][2], const Unit& u, int wr, int wc, int fr, int fq, LAS unsigned char*) const {
        const int col0 = u.g * 256 + wc * 32 + 8 * fq;
        bf16_t* base = O + ((size_t)u.pm * BM + wr * 64 + fr) * D + col0;
        f32x4 bv[2][2], sv[2][2];
#pragma unroll
        for (int bj = 0; bj < 2; ++bj)
#pragma unroll
            for (int n = 0; n < 2; ++n) { bv[bj][n] = *(const f32x4*)(bias + col0 + bj * HALF + 4 * n); sv[bj][n] = *(const f32x4*)(scale + col0 + bj * HALF + 4 * n); }
#pragma unroll
        for (int ai = 0; ai < 2; ++ai)
#pragma unroll
            for (int m = 0; m < 4; ++m) { bf16_t* rowp = base + (size_t)(ai * HALF + m * 16) * D;
#pragma unroll
                for (int bj = 0; bj < 2; ++bj) { const f32x4 v0 = (acc[ai][bj][m][0] + bv[bj][0]) * sv[bj][0], v1 = (acc[ai][bj][m][1] + bv[bj][1]) * sv[bj][1];
                    u32x4 w; w.x = cvt_pk_bf16(v0[0], v0[1]); w.y = cvt_pk_bf16(v0[2], v0[3]); w.z = cvt_pk_bf16(v1[0], v1[1]); w.w = cvt_pk_bf16(v1[2], v1[3]);
                    *(u32x4*)(rowp + bj * HALF) = w; } }
    }
};
struct EpiLru {
    static constexpr bool PERM = true;
    const bf16_t* A2; const float* b_a; const float* b_x; const float* lam; unsigned short* AH; unsigned short* BH;
    __device__ __forceinline__ void operator()(f32x4 (&acc)[2][2][4][2], const Unit& u, int wr, int wc, int fr, int fq, LAS unsigned char*) const {
        const int ch0 = u.g * 128 + wc * 32 + 8 * fq;
        f32x4 ba[2], bx[2], nsp[2];
#pragma unroll
        for (int n = 0; n < 2; ++n) { ba[n] = *(const f32x4*)(b_a + ch0 + 4 * n); bx[n] = *(const f32x4*)(b_x + ch0 + 4 * n); const f32x4 l = *(const f32x4*)(lam + ch0 + 4 * n);
#pragma unroll
            for (int j = 0; j < 4; ++j) nsp[n][j] = -8.0f * log1pf(__expf(-l[j])); }
        u32x4 xw[2][4];
#pragma unroll
        for (int ai = 0; ai < 2; ++ai)
#pragma unroll
            for (int m = 0; m < 4; ++m) { const int row = u.pm * BM + ai * HALF + wr * 64 + m * 16 + fr; xw[ai][m] = *(const u32x4*)(A2 + (size_t)row * D + 1024 + ch0); }
#pragma unroll
        for (int ai = 0; ai < 2; ++ai)
#pragma unroll
            for (int m = 0; m < 4; ++m) { const int row = u.pm * BM + ai * HALF + wr * 64 + m * 16 + fr; const bool first = (row & (SEQ - 1)) == 0;
                const float xc[2][4] = {{bf_lo(xw[ai][m].x), bf_hi(xw[ai][m].x), bf_lo(xw[ai][m].y), bf_hi(xw[ai][m].y)}, {bf_lo(xw[ai][m].z), bf_hi(xw[ai][m].z), bf_lo(xw[ai][m].w), bf_hi(xw[ai][m].w)}};
                float dv[2][4], bv[2][4];
#pragma unroll
                for (int n = 0; n < 2; ++n)
#pragma unroll
                    for (int j = 0; j < 4; ++j) {
                        const float r = sigmoidf_(acc[ai][0][m][n][j] + ba[n][j]);
                        const float ig = sigmoidf_(acc[ai][1][m][n][j] + bx[n][j]);
                        const float la = nsp[n][j] * r;
                        const float a = __expf(la);
                        const float mult = first ? 1.0f : sqrtf(fmaxf(1.0f - a * a, 0.f));
                        dv[n][j] = 1.0f - a; bv[n][j] = mult * ig * xc[n][j]; }
                u32x4 dw, bw;
                dw.x = pk_f16(dv[0][0], dv[0][1]); dw.y = pk_f16(dv[0][2], dv[0][3]); dw.z = pk_f16(dv[1][0], dv[1][1]); dw.w = pk_f16(dv[1][2], dv[1][3]);
                bw.x = pk_f16(bv[0][0], bv[0][1]); bw.y = pk_f16(bv[0][2], bv[0][3]); bw.z = pk_f16(bv[1][0], bv[1][1]); bw.w = pk_f16(bv[1][2], bv[1][3]);
                *(u32x4*)(AH + (size_t)row * 1024 + ch0) = dw; *(u32x4*)(BH + (size_t)row * 1024 + ch0) = bw; }
    }
};
struct EpiSoftmax {
    static constexpr bool PERM = true;
    bf16_t* P; float scale_log2e;
    __device__ __forceinline__ void operator()(f32x4 (&acc)[2][2][4][2], const Unit& u, int wr, int wc, int fr, int fq, LAS unsigned char* lds) const {
        LAS f32x2* X = (LAS f32x2*)(lds + LDS_X);
        float mxs[2][4];
#pragma unroll
        for (int ai = 0; ai < 2; ++ai)
#pragma unroll
            for (int m = 0; m < 4; ++m) {
                float mx = -3.0e38f;
#pragma unroll
                for (int bj = 0; bj < 2; ++bj)
#pragma unroll
                    for (int n = 0; n < 2; ++n) { acc[ai][bj][m][n] = acc[ai][bj][m][n] * scale_log2e; const f32x4 x = acc[ai][bj][m][n]; mx = fmaxf(mx, fmaxf(fmaxf(x[0], x[1]), fmaxf(x[2], x[3]))); }
                mx = fmaxf(mx, __shfl_xor(mx, 16)); mx = fmaxf(mx, __shfl_xor(mx, 32));
                float s = 0.f;
#pragma unroll
                for (int bj = 0; bj < 2; ++bj)
#pragma unroll
                    for (int n = 0; n < 2; ++n) { f32x4 x = acc[ai][bj][m][n];
#pragma unroll
                        for (int j = 0; j < 4; ++j) { x[j] = __builtin_amdgcn_exp2f(x[j] - mx); s += x[j]; }
                        acc[ai][bj][m][n] = x; }
                s += __shfl_xor(s, 16); s += __shfl_xor(s, 32);
                mxs[ai][m] = mx;
                if (fq == 0) X[(ai * HALF + wr * 64 + m * 16 + fr) * 4 + wc] = (f32x2){mx, s};
            }
        asm volatile("s_waitcnt lgkmcnt(0)" ::: "memory"); __builtin_amdgcn_s_barrier(); asm volatile("" ::: "memory");
        bf16_t* base = P + ((size_t)u.g * SEQ + (size_t)u.pm * BM + wr * 64 + fr) * 256 + wc * 32 + 8 * fq;
#pragma unroll
        for (int ai = 0; ai < 2; ++ai)
#pragma unroll
            for (int m = 0; m < 4; ++m) { const int r = ai * HALF + wr * 64 + m * 16 + fr;
                const f32x2 p0 = X[r * 4 + 0], p1 = X[r * 4 + 1], p2 = X[r * 4 + 2], p3 = X[r * 4 + 3];
                const float M = fmaxf(fmaxf(p0.x, p1.x), fmaxf(p2.x, p3.x));
                const float tot = p0.y * __builtin_amdgcn_exp2f(p0.x - M) + p1.y * __builtin_amdgcn_exp2f(p1.x - M) + p2.y * __builtin_amdgcn_exp2f(p2.x - M) + p3.y * __builtin_amdgcn_exp2f(p3.x - M);
                const float f = __builtin_amdgcn_exp2f(mxs[ai][m] - M) / tot;
                bf16_t* rowp = base + (size_t)(ai * HALF + m * 16) * 256;
#pragma unroll
                for (int bj = 0; bj < 2; ++bj) { const f32x4 v0 = acc[ai][bj][m][0] * f, v1 = acc[ai][bj][m][1] * f;
                    u32x4 w; w.x = cvt_pk_bf16(v0[0], v0[1]); w.y = cvt_pk_bf16(v0[2], v0[3]); w.z = cvt_pk_bf16(v1[0], v1[1]); w.w = cvt_pk_bf16(v1[2], v1[3]);
                    *(u32x4*)(rowp + bj * HALF) = w; } }
    }
};

template <class Epi, class Sched, bool ALIGN_EPI, bool SP2>
__device__ __forceinline__ void gemm_phase(LAS unsigned char* lds, const int K_, const Sched& S, const Epi& E) {
    int K = K_; asm volatile("" : "+s"(K));
    int tid_ = threadIdx.x; asm volatile("" : "+v"(tid_));
    const int tid = tid_, wid = __builtin_amdgcn_readfirstlane(tid >> 6), lane = tid & 63, wr = wid >> 2, wc = wid & 3, fr = lane & 15, fq = lane >> 4;
    const int nt = K / BK;
    unsigned voffA[2], voffB[2];
#pragma unroll
    for (int i = 0; i < 2; ++i) { int R, C; stage_rc(tid * 16 + i * 8192, R, C); const int Rb = Epi::PERM ? ((R & ~31) + perm32(R & 31)) : R;
        voffA[i] = (unsigned)(R * S.lda + C) * 2u; voffB[i] = (unsigned)(Rb * S.ldb + C) * 2u; }
    const size_t kstep = (size_t)(BK * 2);
    const size_t hstepA = (size_t)HALF * S.lda * 2, hstepB = (size_t)HALF * S.ldb * 2;
    const unsigned ldsw = (unsigned)wid * 1024u;
    const int aoff = lds_byte(wr * 64 + fr, fq * 8), boff = lds_byte(wc * 32 + fr, fq * 8);
#define PG8_SA(b, h) (((b) * 2 + (h)) * HTB)
#define PG8_SB(b, h) ((4 + (b) * 2 + (h)) * HTB)
#define PG8_STAGE(bufoff, gbase, voff) do { _Pragma("unroll") for (int _i = 0; _i < 2; ++_i) \
        __builtin_amdgcn_global_load_lds((const unsigned*)((const char*)(gbase) + (voff)[_i]), (LAS unsigned*)(lds + (bufoff) + ldsw + _i * 8192), 16, 0, 0); } while (0)
#define PG8_LDA(dst, b, h) do { _Pragma("unroll") for (int m = 0; m < 4; ++m) _Pragma("unroll") for (int k = 0; k < 2; ++k) dst[m][k] = *(const LAS bf16x8*)(lds + PG8_SA(b, h) + aoff + m * 2048 + k * 1024); } while (0)
#define PG8_LDB(dst, b, h) do { _Pragma("unroll") for (int n = 0; n < 2; ++n) _Pragma("unroll") for (int k = 0; k < 2; ++k) dst[n][k] = *(const LAS bf16x8*)(lds + PG8_SB(b, h) + boff + n * 2048 + k * 1024); } while (0)
#define PG8_MMA(ai, bj, At, Bt) do { __builtin_amdgcn_s_setprio(1); _Pragma("unroll") for (int m = 0; m < 4; ++m) _Pragma("unroll") for (int n = 0; n < 2; ++n) _Pragma("unroll") for (int k = 0; k < 2; ++k) \
        acc[ai][bj][m][n] = __builtin_amdgcn_mfma_f32_16x16x32_bf16(Bt[n][k], At[m][k], acc[ai][bj][m][n], 0, 0, 0); __builtin_amdgcn_s_setprio(0); } while (0)
#define PG8_WAIT_V(n) asm volatile("s_waitcnt vmcnt(" #n ")" ::: "memory")
#define PG8_WAIT_L(n) asm volatile("s_waitcnt lgkmcnt(" #n ")" ::: "memory")
#define PG8_BAR __builtin_amdgcn_s_barrier()
#define PG8_SCHED __builtin_amdgcn_sched_barrier(0)
    Unit cur, nxt; int ui = 0;
    if (!S.next(0, cur)) return;
    f32x4 acc[2][2][4][2];
#pragma unroll
    for (int a = 0; a < 2; ++a)
#pragma unroll
        for (int b = 0; b < 2; ++b)
#pragma unroll
            for (int m = 0; m < 4; ++m)
#pragma unroll
                for (int n = 0; n < 2; ++n) acc[a][b][m][n] = (f32x4){0.f, 0.f, 0.f, 0.f};
    bf16x8 At[4][2], B0[2][2], B1[2][2];
    const char* cA = S.a_ptr(cur); const char* cB = S.b_ptr(cur);
    if constexpr (SP2) {
        PG8_STAGE(PG8_SB(0, 0), cB, voffB); PG8_STAGE(PG8_SB(0, 1), cB + hstepB, voffB); PG8_STAGE(PG8_SA(0, 0), cA, voffA); PG8_STAGE(PG8_SA(0, 1), cA + hstepA, voffA);
        if (wr == 1) PG8_BAR;
        PG8_WAIT_V(2); PG8_BAR;
        PG8_STAGE(PG8_SB(1, 0), cB + kstep, voffB); PG8_STAGE(PG8_SA(1, 0), cA + kstep, voffA); PG8_STAGE(PG8_SB(1, 1), cB + hstepB + kstep, voffB);
        PG8_WAIT_V(6); PG8_BAR;
    } else {
        PG8_STAGE(PG8_SB(0, 0), cB, voffB); PG8_STAGE(PG8_SA(0, 0), cA, voffA); PG8_STAGE(PG8_SB(0, 1), cB + hstepB, voffB); PG8_STAGE(PG8_SA(0, 1), cA + hstepA, voffA);
        if (wr == 1) PG8_BAR;
        PG8_WAIT_V(4); PG8_BAR;
        PG8_STAGE(PG8_SB(1, 0), cB + kstep, voffB); PG8_STAGE(PG8_SA(1, 0), cA + kstep, voffA); PG8_STAGE(PG8_SB(1, 1), cB + hstepB + kstep, voffB);
        PG8_WAIT_V(6); PG8_BAR;
    }
    for (;;) {
        const bool has_next = S.next(ui + 1, nxt);
        const char* nA = has_next ? S.a_ptr(nxt) : cA; const char* nB = has_next ? S.b_ptr(nxt) : cB;
        for (int t = 0; t < nt; t += 2) {
            const bool last = (t == nt - 2);
            const char* a1 = cA + (size_t)(t + 1) * kstep;
            const char* a2 = last ? nA : cA + (size_t)(t + 2) * kstep; const char* b2 = last ? nB : cB + (size_t)(t + 2) * kstep;
            const char* a3 = a2 + kstep; const char* b3 = b2 + kstep;
            if constexpr (SP2) {
            PG8_LDB(B0, 0, 0); PG8_LDB(B1, 0, 1); PG8_SCHED; PG8_LDA(At, 0, 0); PG8_STAGE(PG8_SA(1, 1), a1 + hstepA, voffA);
            PG8_WAIT_V(8); PG8_WAIT_L(0); PG8_BAR; PG8_MMA(0, 0, At, B0); PG8_MMA(0, 1, At, B1); PG8_BAR; PG8_SCHED;
            PG8_LDA(At, 0, 1); PG8_STAGE(PG8_SB(0, 0), b2, voffB); PG8_STAGE(PG8_SB(0, 1), b2 + hstepB, voffB); PG8_STAGE(PG8_SA(0, 0), a2, voffA);
            PG8_WAIT_V(8); PG8_WAIT_L(0); PG8_BAR; PG8_MMA(1, 0, At, B0); PG8_MMA(1, 1, At, B1); PG8_BAR; PG8_SCHED;
            PG8_LDB(B0, 1, 0); PG8_LDB(B1, 1, 1); PG8_SCHED; PG8_LDA(At, 1, 0); PG8_STAGE(PG8_SA(0, 1), a2 + hstepA, voffA);
            PG8_WAIT_V(8); PG8_WAIT_L(0); PG8_BAR; PG8_MMA(0, 0, At, B0); PG8_MMA(0, 1, At, B1); PG8_BAR; PG8_SCHED;
            PG8_LDA(At, 1, 1); PG8_STAGE(PG8_SB(1, 0), b3, voffB); PG8_STAGE(PG8_SB(1, 1), b3 + hstepB, voffB); PG8_STAGE(PG8_SA(1, 0), a3, voffA);
            PG8_WAIT_V(8); PG8_WAIT_L(0); PG8_BAR; PG8_MMA(1, 0, At, B0); PG8_MMA(1, 1, At, B1); PG8_BAR; PG8_SCHED;
            } else {
            PG8_LDB(B0, 0, 0); PG8_SCHED; PG8_LDA(At, 0, 0); PG8_STAGE(PG8_SA(1, 1), a1 + hstepA, voffA);
            PG8_WAIT_L(8); PG8_BAR; PG8_WAIT_L(0); PG8_MMA(0, 0, At, B0); PG8_BAR; PG8_SCHED;
            PG8_LDB(B1, 0, 1); PG8_STAGE(PG8_SB(0, 0), b2, voffB);
            PG8_BAR; PG8_WAIT_L(0); PG8_MMA(0, 1, At, B1); PG8_BAR;
            PG8_LDA(At, 0, 1); PG8_STAGE(PG8_SA(0, 0), a2, voffA);
            PG8_BAR; PG8_WAIT_L(0); PG8_MMA(1, 0, At, B0); PG8_BAR; PG8_SCHED;
            PG8_STAGE(PG8_SB(0, 1), b2 + hstepB, voffB);
            PG8_WAIT_V(6); PG8_BAR; PG8_MMA(1, 1, At, B1); PG8_BAR;
            PG8_LDB(B0, 1, 0); PG8_SCHED; PG8_LDA(At, 1, 0); PG8_STAGE(PG8_SA(0, 1), a2 + hstepA, voffA);
            PG8_WAIT_L(8); PG8_BAR; PG8_WAIT_L(0); PG8_MMA(0, 0, At, B0); PG8_BAR; PG8_SCHED;
            PG8_LDB(B1, 1, 1); PG8_STAGE(PG8_SB(1, 0), b3, voffB);
            PG8_BAR; PG8_WAIT_L(0); PG8_MMA(0, 1, At, B1); PG8_BAR;
            PG8_LDA(At, 1, 1); PG8_STAGE(PG8_SA(1, 0), a3, voffA);
            PG8_BAR; PG8_WAIT_L(0); PG8_MMA(1, 0, At, B0); PG8_BAR; PG8_SCHED;
            PG8_STAGE(PG8_SB(1, 1), b3 + hstepB, voffB);
            PG8_WAIT_V(6); PG8_BAR; PG8_MMA(1, 1, At, B1); PG8_BAR;
            }
        }
        if constexpr (ALIGN_EPI) { if (wr == 0) PG8_BAR; }
        E(acc, cur, wr, wc, fr, fq, lds);
        if (!has_next) break;
#pragma unroll
        for (int a = 0; a < 2; ++a)
#pragma unroll
            for (int b = 0; b < 2; ++b)
#pragma unroll
                for (int m = 0; m < 4; ++m)
#pragma unroll
                    for (int n = 0; n < 2; ++n) acc[a][b][m][n] = (f32x4){0.f, 0.f, 0.f, 0.f};
        cur = nxt; cA = nA; cB = nB; ++ui;
        if constexpr (ALIGN_EPI) { if (wr == 1) PG8_BAR; }
    }
    PG8_WAIT_V(0);
    if constexpr (!ALIGN_EPI) { if (wr == 0) PG8_BAR; }
    PG8_BAR;
#undef PG8_SA
#undef PG8_SB
#undef PG8_STAGE
#undef PG8_LDA
#undef PG8_LDB
#undef PG8_MMA
#undef PG8_WAIT_V
#undef PG8_WAIT_L
#undef PG8_BAR
#undef PG8_SCHED
}
}

#ifndef PG8_SP2
#define PG8_SP2 true
#endif

struct TDesc { const float* W; bf16_t* WT; int K, N, row_off, item; };
__device__ __forceinline__ void p0_item_load(const TDesc& d, f32x4 (&v)[16], int lane) {
    const int nblk = d.N / 64, kb = d.item / nblk, nb = d.item % nblk, k0 = 64 * kb, n0 = 64 * nb;
    const int nn = (lane & 15) * 4;
#pragma unroll
    for (int i = 0; i < 16; ++i) { const int kk = 4 * i + (lane >> 4); v[i] = __builtin_nontemporal_load((const f32x4*)(d.W + (size_t)(k0 + kk) * d.N + n0 + nn)); }
}
__device__ __forceinline__ void p0_item_store(const TDesc& d, const f32x4 (&v)[16], LAS float* scr, int lane) {
    const int nblk = d.N / 64, kb = d.item / nblk, nb = d.item % nblk, k0 = 64 * kb, n0 = 64 * nb;
    const int nn = (lane & 15) * 4;
#pragma unroll
    for (int i = 0; i < 16; ++i) { const int kk = 4 * i + (lane >> 4); LAS float* q = scr + kk * 65 + nn; q[0] = v[i][0]; q[1] = v[i][1]; q[2] = v[i][2]; q[3] = v[i][3]; }
    asm volatile("s_waitcnt lgkmcnt(0)" ::: "memory");
    const int c = lane & 7;
#pragma unroll
    for (int j = 0; j < 8; ++j) { const int n = (lane >> 3) + 8 * j; const LAS float* sp = scr + (8 * c) * 65 + n;
        u32x4 o; o.x = cvt_pk_bf16(sp[0 * 65], sp[1 * 65]); o.y = cvt_pk_bf16(sp[2 * 65], sp[3 * 65]); o.z = cvt_pk_bf16(sp[4 * 65], sp[5 * 65]); o.w = cvt_pk_bf16(sp[6 * 65], sp[7 * 65]);
        *(u32x4*)(d.WT + (size_t)(d.row_off + n0 + n) * d.K + k0 + 8 * c) = o; }
    asm volatile("s_waitcnt lgkmcnt(0)" ::: "memory");
}

template <bool RBF>
__device__ __forceinline__ void ln_rows(const void* Rv, const bf16_t* Y, float* O, const float* g, const float* b, bf16_t* XBo, int gw, int NGW, int lane) {
    for (int row = gw; row < T; row += NGW) {
        const bf16_t* yr = Y + (size_t)row * D + 4 * lane;
        f32x4 v[8]; float s = 0.f;
#pragma unroll
        for (int j = 0; j < 8; ++j) {
            f32x4 r;
            if constexpr (RBF) { const u32x2 rw = *(const u32x2*)((const bf16_t*)Rv + (size_t)row * D + 4 * lane + 256 * j); r[0] = bf_lo(rw.x); r[1] = bf_hi(rw.x); r[2] = bf_lo(rw.y); r[3] = bf_hi(rw.y); }
            else r = __builtin_nontemporal_load((const f32x4*)((const float*)Rv + (size_t)row * D + 4 * lane + 256 * j));
            const u32x2 y = *(const u32x2*)(yr + 256 * j);
            v[j][0] = r[0] * ALPHA + bf_lo(y.x); v[j][1] = r[1] * ALPHA + bf_hi(y.x); v[j][2] = r[2] * ALPHA + bf_lo(y.y); v[j][3] = r[3] * ALPHA + bf_hi(y.y);
            s += (v[j][0] + v[j][1]) + (v[j][2] + v[j][3]); }
        const float mean = wave_sum(s) * (1.0f / D); float s2 = 0.f;
#pragma unroll
        for (int j = 0; j < 8; ++j) { v[j] = v[j] - mean; s2 += (v[j][0] * v[j][0] + v[j][1] * v[j][1]) + (v[j][2] * v[j][2] + v[j][3] * v[j][3]); }
        const float rstd = 1.0f / sqrtf(wave_sum(s2) * (1.0f / D) + LN_EPS);
#pragma unroll
        for (int j = 0; j < 8; ++j) { const f32x4 g4 = *(const f32x4*)(g + 4 * lane + 256 * j), b4 = *(const f32x4*)(b + 4 * lane + 256 * j);
            const f32x4 y = v[j] * rstd * g4 + b4;
            if (O) __builtin_nontemporal_store(y, (f32x4*)(O + (size_t)row * D + 4 * lane + 256 * j));
            if (XBo) { u32x2 w; w.x = cvt_pk_bf16(y[0], y[1]); w.y = cvt_pk_bf16(y[2], y[3]); *(u32x2*)(XBo + (size_t)row * D + 4 * lane + 256 * j) = w; } }
    }
}

#define XB_TMO      128
#define XB_XCNT(j)  (256  + 64 * (j))
#define XB_XSUB(j)  (1280 + 64 * (j))
#define XB_XGEN(j)  (2304 + 64 * (j))
#define XB_TOP      3328
#define XB_TOPGEN   3392
#define XCD_BAR_WORDS 3456
#define XB_SPIN_CAP (1u << 18)
__device__ __forceinline__ unsigned xb_ld(unsigned* p)              { return __hip_atomic_load(p, __ATOMIC_RELAXED, __HIP_MEMORY_SCOPE_AGENT); }
__device__ __forceinline__ unsigned xb_add(unsigned* p, unsigned v) { return __hip_atomic_fetch_add(p, v, __ATOMIC_RELAXED, __HIP_MEMORY_SCOPE_AGENT); }
__device__ __forceinline__ unsigned xb_xcc_id() { return (unsigned)__builtin_amdgcn_s_getreg((3 << 11) | 20) & 0xFu; }
#define XB_SPIN(cond, bar) do { unsigned _sp = 0; while (cond) { __builtin_amdgcn_s_sleep(1); \
    if ((++_sp & 255u) == 0u) { if (xb_ld(&(bar)[XB_TMO])) break; if (_sp > XB_SPIN_CAP) { atomicAdd(&(bar)[XB_TMO], 1u); break; } } } } while (0)
struct XcdBarrier { unsigned* bar; unsigned x; volatile LAS unsigned* st; };
__device__ __forceinline__ XcdBarrier xcd_barrier_post(unsigned* bar, volatile LAS unsigned* st) {
    XcdBarrier b; b.bar = bar; b.x = xb_xcc_id(); b.st = st;
    if (threadIdx.x == 0) (void)xb_add(&bar[XB_XCNT(b.x)], 1u);
    return b;
}
__device__ __forceinline__ void xcd_barrier_complete(unsigned* bar, unsigned x, unsigned& nloc, unsigned& nx) {
    const unsigned G = gridDim.x * gridDim.y * gridDim.z;
    unsigned sum, cnt, mine, sp = 0u;
    for (;;) {
        sum = 0u; cnt = 0u; mine = 0u;
#pragma unroll
        for (unsigned j = 0; j < 16; ++j) { const unsigned c = xb_ld(&bar[XB_XCNT(j)]); sum += c; cnt += (c > 0u) ? 1u : 0u; mine = (j == x) ? c : mine; }
        if (sum == G) break;
        __builtin_amdgcn_s_sleep(1);
        if ((++sp & 255u) == 0u) { if (xb_ld(&bar[XB_TMO])) break; if (sp > XB_SPIN_CAP) { atomicAdd(&bar[XB_TMO], 1u); break; } }
    }
    nloc = mine > 0u ? mine : 1u; nx = cnt > 0u ? cnt : 1u;
}
__device__ __forceinline__ void xcd_barrier(const XcdBarrier& b) {
    asm volatile("s_waitcnt vmcnt(0)" ::: "memory");
    __syncthreads();
    if (threadIdx.x == 0) {
        unsigned* bar = b.bar;
        __builtin_amdgcn_s_waitcnt(0);
        unsigned nloc = b.st[0], nx = b.st[1];
        if (nloc == 0u) { xcd_barrier_complete(bar, b.x, nloc, nx); b.st[0] = nloc; b.st[1] = nx; }
        const unsigned old = xb_add(&bar[XB_XSUB(b.x)], 1u);
        const unsigned gen = old / nloc;
        if (old + 1u == (gen + 1u) * nloc) {
            __builtin_amdgcn_fence(__ATOMIC_RELEASE, "agent");
            asm volatile("s_waitcnt vmcnt(0)" ::: "memory");
            const unsigned og = xb_add(&bar[XB_TOP], 1u);
            const unsigned tg = og / nx;
            if (og + 1u == (tg + 1u) * nx) xb_add(&bar[XB_TOPGEN], 1u);
            else XB_SPIN(xb_ld(&bar[XB_TOPGEN]) == tg, bar);
            __builtin_amdgcn_fence(__ATOMIC_ACQUIRE, "agent");
            xb_add(&bar[XB_XGEN(b.x)], 1u);
            asm volatile("s_waitcnt vmcnt(0)" ::: "memory");
        } else {
            XB_SPIN(xb_ld(&bar[XB_XGEN(b.x)]) == gen, bar);
            __builtin_amdgcn_fence(__ATOMIC_ACQUIRE, "agent");
            asm volatile("s_waitcnt vmcnt(0)" ::: "memory");
        }
    }
    __syncthreads();
}

struct Args { const float* in[26]; float* out; unsigned char* ws; int ph_lo, ph_hi; };
constexpr int N_PHASES = 15;

__global__ void __launch_bounds__(512, 2) fwd_mega(Args args) {
    extern __shared__ __attribute__((aligned(16))) unsigned char lds_raw[];
    LAS unsigned char* lds = (LAS unsigned char*)lds_raw;
    const int G = gridDim.x, bid = blockIdx.x;
    const int NGW = G * 8; const long NGT = (long)G * 512;
#define PHASE_IDS() int tid = threadIdx.x; asm volatile("" : "+v"(tid)); const int lane = tid & 63, wave = __builtin_amdgcn_readfirstlane(tid >> 6); \
    const int gw = bid * 8 + wave; const long gt = (long)bid * 512 + tid; (void)lane; (void)gw; (void)gt;
    unsigned char* ws = args.ws;
    const float* x = args.in[0]; const float* mem = args.in[1];
    bf16_t* WIN = (bf16_t*)(ws + WS_WIN); bf16_t* WOUT = (bf16_t*)(ws + WS_WOUT); bf16_t* WQ = (bf16_t*)(ws + WS_WQ); bf16_t* WK = (bf16_t*)(ws + WS_WK);
    bf16_t* WV = (bf16_t*)(ws + WS_WV); bf16_t* WO = (bf16_t*)(ws + WS_WO); bf16_t* WFF1 = (bf16_t*)(ws + WS_WFF1); bf16_t* WFF2 = (bf16_t*)(ws + WS_WFF2);
    bf16_t* WPOOL = (bf16_t*)(ws + WS_WPOOL); bf16_t* WAX = (bf16_t*)(ws + WS_WAX);
    bf16_t* MEMB = (bf16_t*)(ws + WS_MEMB); bf16_t* KB = (bf16_t*)(ws + WS_KB); bf16_t* VT = (bf16_t*)(ws + WS_VT);
    bf16_t* XB = (bf16_t*)(ws + WS_XB); unsigned short* BH = (unsigned short*)(ws + WS_BF); bf16_t* PROJ = (bf16_t*)(ws + WS_PROJ); bf16_t* Y3 = (bf16_t*)(ws + WS_Y3); bf16_t* QB = (bf16_t*)(ws + WS_Q); bf16_t* YB = (bf16_t*)(ws + WS_Q);
    bf16_t* PB = (bf16_t*)(ws + WS_PB); bf16_t* A2 = (bf16_t*)(ws + WS_A2); float* SUMP = (float*)(ws + WS_SUM); float* SUMH = SUMP + 4 * 64 * 1024;
    bf16_t* OB = (bf16_t*)(ws + WS_O); bf16_t* MIX = (bf16_t*)(ws + WS_MIX); unsigned short* AH = (unsigned short*)(ws + WS_AF); bf16_t* HB = (bf16_t*)(ws + WS_H);
    float* out = args.out;
    const int lo = args.ph_lo, hi = args.ph_hi;
#define IN(k) (lo <= (k) && (k) < hi)
#define SEAM(k) do { if (IN(k) && IN((k) + 1)) { xcd_barrier(bar); } } while (0)
    volatile LAS unsigned* bst = (volatile LAS unsigned*)(lds + LDS_BARST);
    if (threadIdx.x < 4) bst[threadIdx.x] = 0u;
    __syncthreads();
    XcdBarrier bar = xcd_barrier_post((unsigned*)(ws + WS_CTL) + 4096, bst);
    if (lo < -1) cg::this_grid().sync();

    if (IN(0)) for (int rep_ = 0; rep_ <= ((PROBE_DUP_MASK >> 0) & 1); ++rep_) {
        PHASE_IDS();
        LAS float* scr = (LAS float*)(lds + wave * 16640);
        constexpr int I_IN = 32 * 48, I_SQ = 32 * 32, I_F1 = 32 * 128, I_F2 = 128 * 32, I_POOL = 4 * 16, I_AX = 16 * 4;
        constexpr int NIT = I_IN + 5 * I_SQ + I_F1 + I_F2 + I_POOL + I_AX;
#define P0_RESOLVE(it_, d_) do { int r = (it_); \
            if (r < I_F1) { d_ = TDesc{args.in[22], WFF1, D, DFF, 0, r}; break; } r -= I_F1; \
            if (r < I_F2) { d_ = TDesc{args.in[23], WFF2, DFF, D, 0, r}; break; } r -= I_F2; \
            if (r < I_IN) { d_ = TDesc{args.in[2], WIN, D, NPROJ, 0, r}; break; } r -= I_IN; \
            if (r < I_SQ) { d_ = TDesc{args.in[13], WOUT, D, D, 0, r}; break; } r -= I_SQ; \
            if (r < I_SQ) { d_ = TDesc{args.in[16], WQ, D, D, 0, r}; break; } r -= I_SQ; \
            if (r < I_SQ) { d_ = TDesc{args.in[17], WK, D, D, 0, r}; break; } r -= I_SQ; \
            if (r < I_SQ) { d_ = TDesc{args.in[18], WV, D, D, 0, r}; break; } r -= I_SQ; \
            if (r < I_SQ) { d_ = TDesc{args.in[19], WO, D, D, 0, r}; break; } r -= I_SQ; \
            if (r < I_POOL) { const int g = r >> 4; d_ = TDesc{args.in[10] + (size_t)g * 65536, WPOOL + (size_t)g * 65536, 256, 256, 0, r & 15}; break; } r -= I_POOL; \
            { const int mtx = r >> 2, h = mtx >> 1, which = mtx & 1;       \
              d_ = TDesc{args.in[which ? 7 : 5] + (size_t)h * 16384, WAX + (size_t)h * 32768, 128, 128, which * 128, r & 3}; } } while (0)
        if (gw < NIT) {
            TDesc dc, dn; f32x4 vc[16], vn[16];
            P0_RESOLVE(gw, dc); p0_item_load(dc, vc, lane);
            for (int it = gw;;) {
                const int itn = it + NGW; const bool has_next = itn < NIT;
                if (has_next) { P0_RESOLVE(itn, dn); p0_item_load(dn, vn, lane); }
                p0_item_store(dc, vc, scr, lane);
                if (!has_next) break;
                dc = dn; it = itn;
#pragma unroll
                for (int i = 0; i < 16; ++i) vc[i] = vn[i];
            }
        }
#undef P0_RESOLVE
#pragma unroll 4
        for (long i = gt; i < (long)T * D / 8; i += NGT) { const f32x4 a = __builtin_nontemporal_load((const f32x4*)(x + i * 8)), b = __builtin_nontemporal_load((const f32x4*)(x + i * 8 + 4));
            u32x4 w; w.x = cvt_pk_bf16(a[0], a[1]); w.y = cvt_pk_bf16(a[2], a[3]); w.z = cvt_pk_bf16(b[0], b[1]); w.w = cvt_pk_bf16(b[2], b[3]); *(u32x4*)(XB + i * 8) = w; }
        for (long i = gt; i < (long)NMEMROWS * D / 8; i += NGT) { const f32x4 a = *(const f32x4*)(mem + i * 8), b = *(const f32x4*)(mem + i * 8 + 4);
            u32x4 w; w.x = cvt_pk_bf16(a[0], a[1]); w.y = cvt_pk_bf16(a[2], a[3]); w.z = cvt_pk_bf16(b[0], b[1]); w.w = cvt_pk_bf16(b[2], b[3]); *(u32x4*)(MEMB + i * 8) = w; }
        __syncthreads();
    }
    SEAM(0);

    if (IN(1)) for (int rep_ = 0; rep_ <= ((PROBE_DUP_MASK >> 1) & 1); ++rep_) {
        { pg8::GSched S; S.init(XB, D, WIN, D, 1, 64, 12, G, bid); pg8::EpiBf16 E{PROJ, NPROJ, 0, 0, 1, 0};
          pg8::gemm_phase<pg8::EpiBf16, pg8::GSched, true, PG8_SP2>(lds, D, S, E); }
    }
    SEAM(1);

    if (IN(2)) for (int rep_ = 0; rep_ <= ((PROBE_DUP_MASK >> 2) & 1); ++rep_) {
        PHASE_IDS();
        const float* conv_w = args.in[3]; const float* conv_b = args.in[4];
        for (long it = gt; it < (long)(T / 32) * 256; it += NGT) {
            const int chunk = (int)(it & 255), r0 = (int)(it >> 8) * 32, pos0 = r0 & (SEQ - 1);
            if (chunk < 128) {
                const int g = chunk >> 5, w = 2 << g;
                const bf16_t* p = PROJ + (size_t)r0 * NPROJ + chunk * 8;
                float s[8];
#pragma unroll
                for (int j = 0; j < 8; ++j) s[j] = 0.f;
                for (int k = 1; k < w; ++k) { if (pos0 - k >= 0) { const u32x4 v = *(const u32x4*)(p - (size_t)k * NPROJ);
                    s[0] += bf_lo(v.x); s[1] += bf_hi(v.x); s[2] += bf_lo(v.y); s[3] += bf_hi(v.y); s[4] += bf_lo(v.z); s[5] += bf_hi(v.z); s[6] += bf_lo(v.w); s[7] += bf_hi(v.w); } }
#pragma unroll 8
                for (int t = 0; t < 32; ++t) {
                    const int pos = pos0 + t;
                    const u32x4 v = *(const u32x4*)(p + (size_t)t * NPROJ);
                    const float u[8] = {bf_lo(v.x), bf_hi(v.x), bf_lo(v.y), bf_hi(v.y), bf_lo(v.z), bf_hi(v.z), bf_lo(v.w), bf_hi(v.w)};
#pragma unroll
                    for (int j = 0; j < 8; ++j) s[j] += u[j];
                    const int cnt = (pos + 1) < w ? (pos + 1) : w; const float inv = 1.0f / (float)cnt;
                    u32x4 o; o.x = cvt_pk_bf16(s[0] * inv - u[0], s[1] * inv - u[1]); o.y = cvt_pk_bf16(s[2] * inv - u[2], s[3] * inv - u[3]);
                    o.z = cvt_pk_bf16(s[4] * inv - u[4], s[5] * inv - u[5]); o.w = cvt_pk_bf16(s[6] * inv - u[6], s[7] * inv - u[7]);
                    *(u32x4*)(A2 + (size_t)(r0 + t) * D + chunk * 8) = o;
                    if (pos + 1 - w >= 0) { const u32x4 q = *(const u32x4*)(p + ((long)t + 1 - w) * NPROJ);
                        s[0] -= bf_lo(q.x); s[1] -= bf_hi(q.x); s[2] -= bf_lo(q.y); s[3] -= bf_hi(q.y); s[4] -= bf_lo(q.z); s[5] -= bf_hi(q.z); s[6] -= bf_lo(q.w); s[7] -= bf_hi(q.w); }
                }
            } else {
                const int c = (chunk - 128) * 8;
                const bf16_t* p = PROJ + (size_t)r0 * NPROJ + 1024 + c;
                float cw[4][8], cb[8];
#pragma unroll
                for (int k = 0; k < 4; ++k) { const f32x4 w0 = *(const f32x4*)(conv_w + k * 1024 + c), w1 = *(const f32x4*)(conv_w + k * 1024 + c + 4);
                    cw[k][0] = w0[0]; cw[k][1] = w0[1]; cw[k][2] = w0[2]; cw[k][3] = w0[3]; cw[k][4] = w1[0]; cw[k][5] = w1[1]; cw[k][6] = w1[2]; cw[k][7] = w1[3]; }
                { const f32x4 b0 = *(const f32x4*)(conv_b + c), b1 = *(const f32x4*)(conv_b + c + 4); cb[0] = b0[0]; cb[1] = b0[1]; cb[2] = b0[2]; cb[3] = b0[3]; cb[4] = b1[0]; cb[5] = b1[1]; cb[6] = b1[2]; cb[7] = b1[3]; }
                const u32x4 zero = {0u, 0u, 0u, 0u};
                u32x4 v0 = zero, v1 = zero, v2 = zero;
                if (pos0 > 0) { v0 = *(const u32x4*)(p - 3 * (size_t)NPROJ); v1 = *(const u32x4*)(p - 2 * (size_t)NPROJ); v2 = *(const u32x4*)(p - (size_t)NPROJ); }
#pragma unroll 8
                for (int t = 0; t < 32; ++t) {
                    const u32x4 v3 = *(const u32x4*)(p + (size_t)t * NPROJ);
                    float s[8];
#pragma unroll
                    for (int j = 0; j < 8; ++j) s[j] = cb[j];
#define CONV_TAP(k, v) s[0] += cw[k][0] * bf_lo(v.x); s[1] += cw[k][1] * bf_hi(v.x); s[2] += cw[k][2] * bf_lo(v.y); s[3] += cw[k][3] * bf_hi(v.y); \
                       s[4] += cw[k][4] * bf_lo(v.z); s[5] += cw[k][5] * bf_hi(v.z); s[6] += cw[k][6] * bf_lo(v.w); s[7] += cw[k][7] * bf_hi(v.w);
                    CONV_TAP(0, v0) CONV_TAP(1, v1) CONV_TAP(2, v2) CONV_TAP(3, v3)
#undef CONV_TAP
                    u32x4 o; o.x = cvt_pk_bf16(s[0], s[1]); o.y = cvt_pk_bf16(s[2], s[3]); o.z = cvt_pk_bf16(s[4], s[5]); o.w = cvt_pk_bf16(s[6], s[7]);
                    *(u32x4*)(A2 + (size_t)(r0 + t) * D + 1024 + c) = o;
                    v0 = v1; v1 = v2; v2 = v3;
                }
            }
        }
    }
    SEAM(2);

    if (IN(3)) for (int rep_ = 0; rep_ <= ((PROBE_DUP_MASK >> 3) & 1); ++rep_) {
        if (bid < 32) { pg8::GSched S; S.init(MEMB, D, WK, D, 1, 4, 8, 32, bid); pg8::EpiBf16 E{KB, D, 0, 0, 1, 0};
          pg8::gemm_phase<pg8::EpiBf16, pg8::GSched, true, PG8_SP2>(lds, D, S, E); }
        else if (bid < 64) { pg8::GSched S; S.init(WV, D, MEMB, D, 1, 8, 4, 32, bid - 32); pg8::EpiBf16 E{VT, NMEMROWS, 0, 0, 1, 0};
          pg8::gemm_phase<pg8::EpiBf16, pg8::GSched, true, PG8_SP2>(lds, D, S, E); }
        else {
        const int G2 = G - 64, c2 = bid - 64;
        { pg8::GSched S; S.init(A2, D, WPOOL, 256, 4, 64, 1, G2, c2); S.ga1 = 256; S.gb1 = 65536; pg8::EpiPool E{MIX, args.in[11], args.in[12]};
          pg8::gemm_phase<pg8::EpiPool, pg8::GSched, true, PG8_SP2>(lds, 256, S, E); }
        { pg8::GSched S; S.init(A2 + 1024, D, WAX, 128, 8, 64, 1, G2, (c2 + 128) % G2); S.ga1 = 128; S.gb1 = 32768; pg8::EpiLru E{A2, args.in[6], args.in[8], args.in[9], AH, BH};
          pg8::gemm_phase<pg8::EpiLru, pg8::GSched, true, PG8_SP2>(lds, 128, S, E); }
        }
    }
    SEAM(3);

    if (IN(4)) for (int rep_ = 0; rep_ <= ((PROBE_DUP_MASK >> 4) & 1); ++rep_) {
        PHASE_IDS();
        for (int it = (int)gt; it < 4 * 64 * 512; it += (int)NGT) {
            const int c2 = it & 511, k = (it >> 9) & 63, b = it >> 15;
            const size_t o0 = ((size_t)b * SEQ + k * 64) * 1024 + 2 * c2;
            const unsigned short* pa = AH + o0; const unsigned short* pb = BH + o0;
            float h0 = 0.f, h1 = 0.f, P0 = 1.f, P1 = 1.f;
#pragma unroll 8
            for (int t = 0; t < 64; ++t) { const unsigned dw = *(const unsigned*)(pa + (size_t)t * 1024), bw = *(const unsigned*)(pb + (size_t)t * 1024);
                const float a0 = 1.0f - h_lo(dw), a1 = 1.0f - h_hi(dw); h0 = a0 * h0 + h_lo(bw); h1 = a1 * h1 + h_hi(bw); P0 *= a0; P1 *= a1; }
            *(f32x2*)(SUMP + (size_t)(b * 64 + k) * 1024 + 2 * c2) = (f32x2){P0, P1}; *(f32x2*)(SUMH + (size_t)(b * 64 + k) * 1024 + 2 * c2) = (f32x2){h0, h1};
        }
    }
    SEAM(4);

    if (IN(5)) for (int rep_ = 0; rep_ <= ((PROBE_DUP_MASK >> 5) & 1); ++rep_) {
        PHASE_IDS();
        for (int it = (int)gt; it < 4 * 64 * 512; it += (int)NGT) {
            const int c2 = it & 511, k = (it >> 9) & 63, b = it >> 15;
            const float* sp = SUMP + (size_t)b * 65536 + 2 * c2; const float* sh = SUMH + (size_t)b * 65536 + 2 * c2;
            float h0 = 0.f, h1 = 0.f;
#pragma unroll 8
            for (int kk = 0; kk < k; ++kk) { const f32x2 p = *(const f32x2*)(sp + kk * 1024), q = *(const f32x2*)(sh + kk * 1024); h0 = h0 * p.x + q.x; h1 = h1 * p.y + q.y; }
            const size_t r0 = (size_t)b * SEQ + k * 64;
            const unsigned short* pa = AH + r0 * 1024 + 2 * c2; const unsigned short* pb = BH + r0 * 1024 + 2 * c2;
            const bf16_t* pg = PROJ + r0 * NPROJ + 2048 + 2 * c2; bf16_t* po = MIX + r0 * D + 1024 + 2 * c2;
#pragma unroll 8
            for (int t = 0; t < 64; ++t) { const unsigned dw = *(const unsigned*)(pa + (size_t)t * 1024), bw = *(const unsigned*)(pb + (size_t)t * 1024), gw2 = *(const unsigned*)(pg + (size_t)t * NPROJ);
                h0 = (1.0f - h_lo(dw)) * h0 + h_lo(bw); h1 = (1.0f - h_hi(dw)) * h1 + h_hi(bw);
                *(unsigned*)(po + (size_t)t * D) = cvt_pk_bf16(h0 * gelu_tanh(bf_lo(gw2)), h1 * gelu_tanh(bf_hi(gw2))); }
        }
    }
    SEAM(5);

    if (IN(6)) for (int rep_ = 0; rep_ <= ((PROBE_DUP_MASK >> 6) & 1); ++rep_) {
        pg8::GSched S; S.init(MIX, D, WOUT, D, 1, 64, 8, G, bid); pg8::EpiBf16 E{YB, D, 0, 0, 1, 0};
        pg8::gemm_phase<pg8::EpiBf16, pg8::GSched, true, PG8_SP2>(lds, D, S, E);
    }
    SEAM(6);
    if (IN(7)) for (int rep_ = 0; rep_ <= ((PROBE_DUP_MASK >> 7) & 1); ++rep_) { PHASE_IDS(); ln_rows<false>(x, YB, nullptr, args.in[14], args.in[15], XB, gw, NGW, lane); }
    SEAM(7);
    if (IN(8)) for (int rep_ = 0; rep_ <= ((PROBE_DUP_MASK >> 8) & 1); ++rep_) {
        pg8::GSched S; S.init(XB, D, WQ, D, 1, 64, 8, G, bid); pg8::EpiBf16 E{QB, D, 0, 0, 1, 0};
        pg8::gemm_phase<pg8::EpiBf16, pg8::GSched, true, PG8_SP2>(lds, D, S, E);
    }
    SEAM(8);
    if (IN(9)) for (int rep_ = 0; rep_ <= ((PROBE_DUP_MASK >> 9) & 1); ++rep_) {
        pg8::GSched S; S.init(QB, D, KB, D, 16, 16, 1, G, bid); S.gdiv = 4; S.ga1 = (long)SEQ * D; S.ga0 = 512; S.gb1 = 256L * D; S.gb0 = 512;
        pg8::EpiSoftmax E{PB, 0.04419417382415922f * 1.4426950408889634f};
        pg8::gemm_phase<pg8::EpiSoftmax, pg8::GSched, true, PG8_SP2>(lds, 512, S, E);
    }
    SEAM(9);
    if (IN(10)) for (int rep_ = 0; rep_ <= ((PROBE_DUP_MASK >> 10) & 1); ++rep_) {
        pg8::GSched S; S.init(PB, 256, VT, NMEMROWS, 16, 16, 2, G, bid); S.gdiv = 4; S.ga1 = 4L * SEQ * 256; S.ga0 = (long)SEQ * 256; S.gb1 = 256; S.gb0 = 512L * NMEMROWS;
        pg8::EpiBf16 E{OB, D, (long)SEQ * D, 512, 4, 0};
        pg8::gemm_phase<pg8::EpiBf16, pg8::GSched, true, PG8_SP2>(lds, 256, S, E);
    }
    SEAM(10);
    if (IN(11)) for (int rep_ = 0; rep_ <= ((PROBE_DUP_MASK >> 11) & 1); ++rep_) {
        pg8::GSched S; S.init(OB, D, WO, D, 1, 64, 8, G, bid); pg8::EpiBf16 E{YB, D, 0, 0, 1, 0};
        pg8::gemm_phase<pg8::EpiBf16, pg8::GSched, true, PG8_SP2>(lds, D, S, E);
    }
    SEAM(11);
    if (IN(12)) for (int rep_ = 0; rep_ <= ((PROBE_DUP_MASK >> 12) & 1); ++rep_) { PHASE_IDS(); ln_rows<true>(XB, YB, nullptr, args.in[20], args.in[21], XB, gw, NGW, lane); }
    SEAM(12);
    constexpr size_t CH_ROWS = T / 2;
    if (IN(13)) {
        { pg8::GSched S; S.init(XB, D, WFF1, D, 1, 32, 32, G, bid); pg8::EpiBf16 E{HB, DFF, 0, 0, 1, 1};
          pg8::gemm_phase<pg8::EpiBf16, pg8::GSched, true, PG8_SP2>(lds, D, S, E); }
        xcd_barrier(bar);
        { pg8::GSched S; S.init(HB, DFF, WFF2, DFF, 1, 32, 8, G, bid); pg8::EpiBf16 E{Y3, D, 0, 0, 1, 0};
          pg8::gemm_phase<pg8::EpiBf16, pg8::GSched, true, PG8_SP2>(lds, DFF, S, E); }
        { pg8::GSched S; S.init(XB + CH_ROWS * D, D, WFF1, D, 1, 32, 32, G, bid); pg8::EpiBf16 E{HB + CH_ROWS * DFF, DFF, 0, 0, 1, 1};
          pg8::gemm_phase<pg8::EpiBf16, pg8::GSched, true, PG8_SP2>(lds, D, S, E); }
    }
    SEAM(13);
    if (IN(14)) {
        pg8::GSched S; S.init(HB + CH_ROWS * DFF, DFF, WFF2, DFF, 1, 32, 8, G, bid); pg8::EpiBf16 E{Y3 + CH_ROWS * D, D, 0, 0, 1, 0};
        pg8::gemm_phase<pg8::EpiBf16, pg8::GSched, true, PG8_SP2>(lds, DFF, S, E);
    }
    SEAM(14);
    if (IN(15)) for (int rep_ = 0; rep_ <= ((PROBE_DUP_MASK >> 15) & 1); ++rep_) { PHASE_IDS(); ln_rows<true>(XB, Y3, out, args.in[24], args.in[25], nullptr, gw, NGW, lane); }
#undef IN
#undef SEAM
}

extern "C" void kernel_launch(void* const* d_in, const int* in_sizes, int n_in, void* d_out, int out_size, void* d_ws, size_t ws_size, hipStream_t stream) {
    static int grid = 0;
    if (grid == 0) {
        if (n_in != 26 || out_size != T * D || ws_size < WS_END) { fprintf(stderr, "kernel_launch: unexpected shapes (n_in %d out %d ws %zu)\n", n_in, out_size, ws_size); grid = -1; return; }
        int dev = 0, cus = 0, per_cu = 0;
        (void)hipGetDevice(&dev);
        (void)hipDeviceGetAttribute(&cus, hipDeviceAttributeMultiprocessorCount, dev);
        if (hipFuncSetAttribute((const void*)fwd_mega, hipFuncAttributeMaxDynamicSharedMemorySize, LDS_BYTES) != hipSuccess) { fprintf(stderr, "kernel_launch: hipFuncSetAttribute failed\n"); grid = -1; return; }
        if (hipOccupancyMaxActiveBlocksPerMultiprocessor(&per_cu, (const void*)fwd_mega, 512, LDS_BYTES) != hipSuccess || per_cu < 1) { fprintf(stderr, "kernel_launch: occupancy query says %d\n", per_cu); grid = -1; return; }
        grid = cus;
        if (grid % 8 != 0 || grid > 1024) { fprintf(stderr, "kernel_launch: unexpected CU count %d\n", cus); }
    }
    if (grid < 0) return;
    if (hipMemsetAsync((char*)d_ws + WS_CTL, 0, 64 * 1024, stream) != hipSuccess) { fprintf(stderr, "kernel_launch: memset failed\n"); return; }
    Args a{};
    for (int i = 0; i < 26; ++i) a.in[i] = (const float*)d_in[i];
    a.out = (float*)d_out; a.ws = (unsigned char*)d_ws;
#if MK_N_LAUNCHES == 1
#if PROBE_PREFIX >= 0
    { a.ph_lo = 0; a.ph_hi = PROBE_PREFIX + 1; void* kargs0[] = {&a};
      (void)hipLaunchCooperativeKernel((const void*)fwd_mega, dim3(grid), dim3(512), kargs0, LDS_BYTES, stream);
      (void)hipMemsetAsync((char*)d_ws + WS_CTL, 0, 64 * 1024, stream); }
#endif
    a.ph_lo = 0; a.ph_hi = N_PHASES + 1;
    void* kargs[] = {&a};
    hipError_t e = hipLaunchCooperativeKernel((const void*)fwd_mega, dim3(grid), dim3(512), kargs, LDS_BYTES, stream);
    if (e != hipSuccess) fprintf(stderr, "kernel_launch: cooperative launch failed: %s (grid %d)\n", hipGetErrorString(e), grid);
#else
    for (int p = 0; p <= N_PHASES; ++p) { a.ph_lo = p; a.ph_hi = p + 1; hipLaunchKernelGGL(fwd_mega, dim3(grid), dim3(512), LDS_BYTES, stream, a); }
#endif
}
```

```cpp
#include <hip/hip_runtime.h>
#include <hip/hip_cooperative_groups.h>
#include <cstdio>
#include <cstdint>
namespace cg = cooperative_groups;

#ifndef PROBE_DUP_MASK
#define PROBE_DUP_MASK 0
#endif
#ifndef PROBE_LN
#define PROBE_LN 0
#endif
#ifndef PROBE_PREFIX
#define PROBE_PREFIX -1
#endif
#ifndef MK_N_LAUNCHES
#define MK_N_LAUNCHES 1
#endif

#define LAS __attribute__((address_space(3)))
typedef unsigned short bf16_t;
typedef short bf16x8 __attribute__((ext_vector_type(8)));
typedef float f32x4 __attribute__((ext_vector_type(4)));
typedef float f32x2 __attribute__((ext_vector_type(2)));
typedef unsigned u32x4 __attribute__((ext_vector_type(4)));
typedef unsigned u32x2 __attribute__((ext_vector_type(2)));
typedef _Float16 f16x2 __attribute__((ext_vector_type(2)));

constexpr int T = 16384, SEQ = 4096, D = 2048, NPROJ = 3072, DFF = 8192, NMEMROWS = 1024;
constexpr float LN_EPS = 1e-5f;
constexpr float ALPHA = 1.189207115002721f;

constexpr size_t MiB = 1u << 20;
constexpr size_t WS_CTL = 0, CTL_BYTES = 1 * MiB;
constexpr size_t CTL_C1 = 64 * 1024, CTL_C2 = 96 * 1024, CTL_STATS2 = 128 * 1024, CTL_ZERO = 256 * 1024;
constexpr size_t WS_WFF1 = 2 * MiB, WS_WFF2 = 34 * MiB, WS_WIN = 66 * MiB, WS_WOUT = 78 * MiB, WS_WQ = 86 * MiB, WS_WK = 94 * MiB, WS_WV = 102 * MiB, WS_WO = 110 * MiB;
constexpr size_t WS_Y3 = 66 * MiB;
constexpr size_t WS_WPOOL = 118 * MiB, WS_WAX = 118 * MiB + 512 * 1024;
constexpr size_t WS_MEMB = 119 * MiB, WS_KB = 123 * MiB, WS_VT = 127 * MiB;
constexpr size_t WS_XB = 131 * MiB;
constexpr size_t WS_BF = 131 * MiB;
constexpr size_t WS_PROJ = 195 * MiB;
constexpr size_t WS_Q = 195 * MiB;
constexpr size_t WS_PB = 259 * MiB;
constexpr size_t WS_A2 = 291 * MiB;
constexpr size_t WS_SUM = 291 * MiB;
constexpr size_t WS_O = 291 * MiB;
constexpr size_t WS_MIX = 355 * MiB;
constexpr size_t WS_AF = 419 * MiB;
constexpr size_t WS_H = 195 * MiB;
constexpr size_t WS_END = 483 * MiB;

constexpr int LDS_BYTES = 147456;
constexpr int LDS_X = 131072;
constexpr int LDS_BARST = 131072 + 8192;

__device__ __forceinline__ unsigned cvt_pk_bf16(float lo, float hi) { unsigned r; asm volatile("v_cvt_pk_bf16_f32 %0, %1, %2" : "=v"(r) : "v"(lo), "v"(hi)); return r; }
__device__ __forceinline__ float bf_lo(unsigned w) { return __uint_as_float(w << 16); }
__device__ __forceinline__ float bf_hi(unsigned w) { return __uint_as_float(w & 0xffff0000u); }
__device__ __forceinline__ float bf2f(bf16_t b) { return __uint_as_float(((unsigned)b) << 16); }
__device__ __forceinline__ bf16_t f2bf(float f) { unsigned u = __float_as_uint(f); return (bf16_t)((u + 0x7fffu + ((u >> 16) & 1u)) >> 16); }
__device__ __forceinline__ float wave_sum(float v) {
#pragma unroll
    for (int o = 1; o < 64; o <<= 1) v += __shfl_xor(v, o);
    return v;
}
__device__ __forceinline__ unsigned pk_f16(float lo, float hi) { f16x2 v; v.x = (_Float16)lo; v.y = (_Float16)hi; return __builtin_bit_cast(unsigned, v); }
__device__ __forceinline__ float h_lo(unsigned w) { return (float)__builtin_bit_cast(f16x2, w).x; }
__device__ __forceinline__ float h_hi(unsigned w) { return (float)__builtin_bit_cast(f16x2, w).y; }
__device__ __forceinline__ float sigmoidf_(float x) { return 1.0f / (1.0f + __expf(-x)); }
__device__ __forceinline__ float gelu_tanh(float x) {
    const float z = 0.7978845608028654f * (x + 0.044715f * x * x * x);
    const float e = __expf(2.0f * z);
    const float th = 1.0f - 2.0f / (e + 1.0f);
    return 0.5f * x * (1.0f + th);
}

namespace pg8 {
constexpr int BM = 256, BK = 64, HALF = 128, HTB = HALF * BK * 2, STAGE_BYTES = 8 * HTB, NXCD = 8, WGM = 8;
__host__ __device__ __forceinline__ int lds_byte(int r, int c) { const int st = (r >> 4) * 2 + (c >> 5), rr = r & 15, cc = c & 31, ob = rr * 64 + cc * 2; return st * 1024 + (ob ^ (((ob >> 9) & 1) << 5)); }
__host__ __device__ __forceinline__ void stage_rc(int b, int& R, int& C) { const int st = b / 1024, sb = b % 1024, swz = sb ^ (((sb >> 9) & 1) << 5); R = (st >> 1) * 16 + swz / 64; C = (st & 1) * 32 + (swz % 64) / 2; }
__host__ __device__ __forceinline__ int perm32(int rho) { const int n = rho >> 4, i = rho & 15; return 8 * (i >> 2) + 4 * n + (i & 3); }

struct Unit { int pm, pn, g; };

struct GSched {
    const bf16_t* A; const bf16_t* Bt;
    long ga1, ga0, gb1, gb0; int gdiv;
    int lda, ldb, nMg, nVM, nN, nwg, G, c;
    __device__ __forceinline__ void init(const bf16_t* A_, int lda_, const bf16_t* Bt_, int ldb_, int nG, int nMg_, int nN_, int G_, int c_) {
        A = A_; Bt = Bt_; lda = lda_; ldb = ldb_; nMg = nMg_; nVM = nG * nMg_; nN = nN_; nwg = nVM * nN_; G = G_; c = c_;
        ga1 = ga0 = gb1 = gb0 = 0; gdiv = 1;
    }
    __device__ __forceinline__ bool next(int i, Unit& u) const {
        const long L = (long)i * G + c; if (L >= nwg) return false;
        int wgid = (int)L; { const int q = nwg / NXCD, r = nwg % NXCD, xcd = wgid % NXCD, off = wgid / NXCD; wgid = (xcd < r ? xcd * (q + 1) : r * (q + 1) + (xcd - r) * q) + off; }
        const int nig = WGM * nN, gid = wgid / nig, fm = gid * WGM, gsz = (nVM - fm) < WGM ? (nVM - fm) : WGM;
        const int vm = fm + ((wgid % nig) % gsz); u.pn = (wgid % nig) / gsz; u.g = vm / nMg; u.pm = vm % nMg; return true;
    }
    __device__ __forceinline__ const char* a_ptr(const Unit& u) const { return (const char*)(A + (long)(u.g / gdiv) * ga1 + (long)(u.g % gdiv) * ga0 + (long)u.pm * BM * lda); }
    __device__ __forceinline__ const char* b_ptr(const Unit& u) const { return (const char*)(Bt + (long)(u.g / gdiv) * gb1 + (long)(u.g % gdiv) * gb0 + (long)u.pn * BM * ldb); }
};

struct EpiBf16 {
    static constexpr bool PERM = true;
    bf16_t* O; int ldc; long go1, go0; int gdiv; int act;
    __device__ __forceinline__ void operator()(f32x4 (&acc)[2][2][4][2], const Unit& u, int wr, int wc, int fr, int fq, LAS unsigned char*) const {
        bf16_t* base = O + (long)(u.g / gdiv) * go1 + (long)(u.g % gdiv) * go0 + ((size_t)u.pm * BM + wr * 64 + fr) * ldc + u.pn * BM + wc * 32 + 8 * fq;
#pragma unroll
        for (int ai = 0; ai < 2; ++ai)
#pragma unroll
            for (int m = 0; m < 4; ++m) { bf16_t* rowp = base + (size_t)(ai * HALF + m * 16) * ldc;
#pragma unroll
                for (int bj = 0; bj < 2; ++bj) { f32x4 v0 = acc[ai][bj][m][0], v1 = acc[ai][bj][m][1];
                    if (act == 1) {
#pragma unroll
                        for (int j = 0; j < 4; ++j) { const float a0 = fmaxf(v0[j], 0.f), a1 = fmaxf(v1[j], 0.f); v0[j] = a0 * a0; v1[j] = a1 * a1; } }
                    u32x4 w; w.x = cvt_pk_bf16(v0[0], v0[1]); w.y = cvt_pk_bf16(v0[2], v0[3]); w.z = cvt_pk_bf16(v1[0], v1[1]); w.w = cvt_pk_bf16(v1[2], v1[3]);
                    *(u32x4*)(rowp + bj * HALF) = w; } }
    }
};
struct EpiResStat {
    static constexpr bool PERM = true;
    bf16_t* X; float* stats;
    __device__ __forceinline__ void operator()(f32x4 (&acc)[2][2][4][2], const Unit& u, int wr, int wc, int fr, int fq, LAS unsigned char*) const {
        bf16_t* base = X + ((size_t)u.pm * BM + wr * 64 + fr) * D + u.pn * BM + wc * 32 + 8 * fq;
        u32x4 xr[2][4][2];
#pragma unroll
        for (int ai = 0; ai < 2; ++ai)
#pragma unroll
            for (int m = 0; m < 4; ++m)
#pragma unroll
                for (int bj = 0; bj < 2; ++bj) xr[ai][m][bj] = *(const u32x4*)(base + (size_t)(ai * HALF + m * 16) * D + bj * HALF);
#pragma unroll
        for (int ai = 0; ai < 2; ++ai)
#pragma unroll
            for (int m = 0; m < 4; ++m) { float s = 0.f, q = 0.f;
#pragma unroll
                for (int bj = 0; bj < 2; ++bj) { const u32x4 x = xr[ai][m][bj]; const f32x4 a0 = acc[ai][bj][m][0], a1 = acc[ai][bj][m][1];
                    u32x4 w; w.x = cvt_pk_bf16(bf_lo(x.x) * ALPHA + a0[0], bf_hi(x.x) * ALPHA + a0[1]); w.y = cvt_pk_bf16(bf_lo(x.y) * ALPHA + a0[2], bf_hi(x.y) * ALPHA + a0[3]);
                    w.z = cvt_pk_bf16(bf_lo(x.z) * ALPHA + a1[0], bf_hi(x.z) * ALPHA + a1[1]); w.w = cvt_pk_bf16(bf_lo(x.w) * ALPHA + a1[2], bf_hi(x.w) * ALPHA + a1[3]);
                    const float z[8] = {bf_lo(w.x), bf_hi(w.x), bf_lo(w.y), bf_hi(w.y), bf_lo(w.z), bf_hi(w.z), bf_lo(w.w), bf_hi(w.w)};
#pragma unroll
                    for (int e = 0; e < 8; ++e) { s += z[e]; q += z[e] * z[e]; }
                    *(u32x4*)(base + (size_t)(ai * HALF + m * 16) * D + bj * HALF) = w; }
                s += __shfl_xor(s, 16); s += __shfl_xor(s, 32); q += __shfl_xor(q, 16); q += __shfl_xor(q, 32);
                if (fq == 0) { float* st = stats + 2 * ((size_t)u.pm * BM + ai * HALF + wr * 64 + m * 16 + fr);
                    __hip_atomic_fetch_add(st, s, __ATOMIC_RELAXED, __HIP_MEMORY_SCOPE_AGENT); __hip_atomic_fetch_add(st + 1, q, __ATOMIC_RELAXED, __HIP_MEMORY_SCOPE_AGENT); } }
    }
};
struct EpiFF1 {
    static constexpr bool PERM = true;
    bf16_t* O; const float* stats; const float* c1; const float* c2; int row0;
    __device__ __forceinline__ void operator()(f32x4 (&acc)[2][2][4][2], const Unit& u, int wr, int wc, int fr, int fq, LAS unsigned char*) const {
        const int col0 = u.pn * BM + wc * 32 + 8 * fq;
        bf16_t* base = O + ((size_t)u.pm * BM + wr * 64 + fr) * DFF + col0;
        f32x4 c1v[2][2], c2v[2][2];
#pragma unroll
        for (int bj = 0; bj < 2; ++bj)
#pragma unroll
            for (int n = 0; n < 2; ++n) { c1v[bj][n] = *(const f32x4*)(c1 + col0 + bj * HALF + 4 * n); c2v[bj][n] = *(const f32x4*)(c2 + col0 + bj * HALF + 4 * n); }
        f32x2 st[2][4];
#pragma unroll
        for (int ai = 0; ai < 2; ++ai)
#pragma unroll
            for (int m = 0; m < 4; ++m) st[ai][m] = *(const f32x2*)(stats + 2 * ((size_t)row0 + (size_t)u.pm * BM + ai * HALF + wr * 64 + m * 16 + fr));
#pragma unroll
        for (int ai = 0; ai < 2; ++ai)
#pragma unroll
            for (int m = 0; m < 4; ++m) { bf16_t* rowp = base + (size_t)(ai * HALF + m * 16) * DFF;
                const float mean = st[ai][m].x * (1.0f / D); const float var = fmaxf(st[ai][m].y * (1.0f / D) - mean * mean, 0.f); const float rstd = 1.0f / sqrtf(var + LN_EPS);
#pragma unroll
                for (int bj = 0; bj < 2; ++bj) { f32x4 v0 = (acc[ai][bj][m][0] - c1v[bj][0] * mean) * rstd + c2v[bj][0], v1 = (acc[ai][bj][m][1] - c1v[bj][1] * mean) * rstd + c2v[bj][1];
#pragma unroll
                    for (int j = 0; j < 4; ++j) { const float a0 = fmaxf(v0[j], 0.f), a1 = fmaxf(v1[j], 0.f); v0[j] = a0 * a0; v1[j] = a1 * a1; }
                    u32x4 w; w.x = cvt_pk_bf16(v0[0], v0[1]); w.y = cvt_pk_bf16(v0[2], v0[3]); w.z = cvt_pk_bf16(v1[0], v1[1]); w.w = cvt_pk_bf16(v1[2], v1[3]);
                    *(u32x4*)(rowp + bj * HALF) = w; } }
    }
};
struct EpiPool {
    static constexpr bool PERM = true;
    bf16_t* O; const float* bias; const float* scale;
    __device__ __forceinline__ void operator()(f32x4 (&acc)[2][2][4][2], const Unit& u, int wr, int wc, int fr, int fq, LAS unsigned char*) const {
        const int col0 = u.g * 256 + wc * 32 + 8 * fq;
        bf16_t* base = O + ((size_t)u.pm * BM + wr * 64 + fr) * D + col0;
        f32x4 bv[2][2], sv[2][2];
#pragma unroll
        for (int bj = 0; bj < 2; ++bj)
#pragma unroll
            for (int n = 0; n < 2; ++n) { bv[bj][n] = *(const f32x4*)(bias + col0 + bj * HALF + 4 * n); sv[bj][n] = *(const f32x4*)(scale + col0 + bj * HALF + 4 * n); }
#pragma unroll
        for (int ai = 0; ai < 2; ++ai)
#pragma unroll
            for (int m = 0; m < 4; ++m) { bf16_t* rowp = base + (size_t)(ai * HALF + m * 16) * D;
#pragma unroll
                for (int bj = 0; bj < 2; ++bj) { const f32x4 v0 = (acc[ai][bj][m][0] + bv[bj][0]) * sv[bj][0], v1 = (acc[ai][bj][m][1] + bv[bj][1]) * sv[bj][1];
                    u32x4 w; w.x = cvt_pk_bf16(v0[0], v0[1]); w.y = cvt_pk_bf16(v0[2], v0[3]); w.z = cvt_pk_bf16(v1[0], v1[1]); w.w = cvt_pk_bf16(v1[2], v1[3]);
                    *(u32x4*)(rowp + bj * HALF) = w; } }
    }
};
struct EpiLru {
    static constexpr bool PERM = true;
    const bf16_t* A2; const float* b_a; const float* b_x; const float* lam; unsigned short* AH; unsigned short* BH;
    __device__ __forceinline__ void operator()(f32x4 (&acc)[2][2][4][2], const Unit& u, int wr, int wc, int fr, int fq, LAS unsigned char*) const {
        const int ch0 = u.g * 128 + wc * 32 + 8 * fq;
        f32x4 ba[2], bx[2], nsp[2];
#pragma unroll
        for (int n = 0; n < 2; ++n) { ba[n] = *(const f32x4*)(b_a + ch0 + 4 * n); bx[n] = *(const f32x4*)(b_x + ch0 + 4 * n); const f32x4 l = *(const f32x4*)(lam + ch0 + 4 * n);
#pragma unroll
            for (int j = 0; j < 4; ++j) nsp[n][j] = -8.0f * log1pf(__expf(-l[j])); }
        u32x4 xw[2][4];
#pragma unroll
        for (int ai = 0; ai < 2; ++ai)
#pragma unroll
            for (int m = 0; m < 4; ++m) { const int row = u.pm * BM + ai * HALF + wr * 64 + m * 16 + fr; xw[ai][m] = *(const u32x4*)(A2 + (size_t)row * D + 1024 + ch0); }
#pragma unroll
        for (int ai = 0; ai < 2; ++ai)
#pragma unroll
            for (int m = 0; m < 4; ++m) { const int row = u.pm * BM + ai * HALF + wr * 64 + m * 16 + fr; const bool first = (row & (SEQ - 1)) == 0;
                const float xc[2][4] = {{bf_lo(xw[ai][m].x), bf_hi(xw[ai][m].x), bf_lo(xw[ai][m].y), bf_hi(xw[ai][m].y)}, {bf_lo(xw[ai][m].z), bf_hi(xw[ai][m].z), bf_lo(xw[ai][m].w), bf_hi(xw[ai][m].w)}};
                float dv[2][4], bv[2][4];
#pragma unroll
                for (int n = 0; n < 2; ++n)
#pragma unroll
                    for (int j = 0; j < 4; ++j) {
                        const float r = sigmoidf_(acc[ai][0][m][n][j] + ba[n][j]);
                        const float ig = sigmoidf_(acc[ai][1][m][n][j] + bx[n][j]);
                        const float la = nsp[n][j] * r;
                        const float a = __expf(la);
                        const float mult = first ? 1.0f : sqrtf(fmaxf(1.0f - a * a, 0.f));
                        dv[n][j] = 1.0f - a; bv[n][j] = mult * ig * xc[n][j]; }
                u32x4 dw, bw;
                dw.x = pk_f16(dv[0][0], dv[0][1]); dw.y = pk_f16(dv[0][2], dv[0][3]); dw.z = pk_f16(dv[1][0], dv[1][1]); dw.w = pk_f16(dv[1][2], dv[1][3]);
                bw.x = pk_f16(bv[0][0], bv[0][1]); bw.y = pk_f16(bv[0][2], bv[0][3]); bw.z = pk_f16(bv[1][0], bv[1][1]); bw.w = pk_f16(bv[1][2], bv[1][3]);
                *(u32x4*)(AH + (size_t)row * 1024 + ch0) = dw; *(u32x4*)(BH + (size_t)row * 1024 + ch0) = bw; }
    }
};
struct EpiSoftmax {
    static constexpr bool PERM = true;
    bf16_t* P; float scale_log2e;
    __device__ __forceinline__ void operator()(f32x4 (&acc)[2][2][4][2], const Unit& u, int wr, int wc, int fr, int fq, LAS unsigned char* lds) const {
        LAS f32x2* X = (LAS f32x2*)(lds + LDS_X);
        float mxs[2][4];
#pragma unroll
        for (int ai = 0; ai < 2; ++ai)
#pragma unroll
            for (int m = 0; m < 4; ++m) {
                float mx = -3.0e38f;
#pragma unroll
                for (int bj = 0; bj < 2; ++bj)
#pragma unroll
                    for (int n = 0; n < 2; ++n) { acc[ai][bj][m][n] = acc[ai][bj][m][n] * scale_log2e; const f32x4 x = acc[ai][bj][m][n]; mx = fmaxf(mx, fmaxf(fmaxf(x[0], x[1]), fmaxf(x[2], x[3]))); }
                mx = fmaxf(mx, __shfl_xor(mx, 16)); mx = fmaxf(mx, __shfl_xor(mx, 32));
                float s = 0.f;
#pragma unroll
                for (int bj = 0; bj < 2; ++bj)
#pragma unroll
                    for (int n = 0; n < 2; ++n) { f32x4 x = acc[ai][bj][m][n];
#pragma unroll
                        for (int j = 0; j < 4; ++j) { x[j] = __builtin_amdgcn_exp2f(x[j] - mx); s += x[j]; }
                        acc[ai][bj][m][n] = x; }
                s += __shfl_xor(s, 16); s += __shfl_xor(s, 32);
                mxs[ai][m] = mx;
                if (fq == 0) X[(ai * HALF + wr * 64 + m * 16 + fr) * 4 + wc] = (f32x2){mx, s};
            }
        asm volatile("s_waitcnt lgkmcnt(0)" ::: "memory"); __builtin_amdgcn_s_barrier(); asm volatile("" ::: "memory");
        bf16_t* base = P + ((size_t)u.g * SEQ + (size_t)u.pm * BM + wr * 64 + fr) * 256 + wc * 32 + 8 * fq;
#pragma unroll
        for (int ai = 0; ai < 2; ++ai)
#pragma unroll
            for (int m = 0; m < 4; ++m) { const int r = ai * HALF + wr * 64 + m * 16 + fr;
                const f32x2 p0 = X[r * 4 + 0], p1 = X[r * 4 + 1], p2 = X[r * 4 + 2], p3 = X[r * 4 + 3];
                const float M = fmaxf(fmaxf(p0.x, p1.x), fmaxf(p2.x, p3.x));
                const float tot = p0.y * __builtin_amdgcn_exp2f(p0.x - M) + p1.y * __builtin_amdgcn_exp2f(p1.x - M) + p2.y * __builtin_amdgcn_exp2f(p2.x - M) + p3.y * __builtin_amdgcn_exp2f(p3.x - M);
                const float f = __builtin_amdgcn_exp2f(mxs[ai][m] - M) / tot;
                bf16_t* rowp = base + (size_t)(ai * HALF + m * 16) * 256;
#pragma unroll
                for (int bj = 0; bj < 2; ++bj) { const f32x4 v0 = acc[ai][bj][m][0] * f, v1 = acc[ai][bj][m][1] * f;
                    u32x4 w; w.x = cvt_pk_bf16(v0[0], v0[1]); w.y = cvt_pk_bf16(v0[2], v0[3]); w.z = cvt_pk_bf16(v1[0], v1[1]); w.w = cvt_pk_bf16(v1[2], v1[3]);
                    *(u32x4*)(rowp + bj * HALF) = w; } }
    }
};

template <class Epi, class Sched, bool ALIGN_EPI, bool SP2>
__device__ __forceinline__ void gemm_phase(LAS unsigned char* lds, const int K_, const Sched& S, const Epi& E) {
    int K = K_; asm volatile("" : "+s"(K));
    int tid_ = threadIdx.x; asm volatile("" : "+v"(tid_));
    const int tid = tid_, wid = __builtin_amdgcn_readfirstlane(tid >> 6), lane = tid & 63, wr = wid >> 2, wc = wid & 3, fr = lane & 15, fq = lane >> 4;
    const int nt = K / BK;
    unsigned voffA[2], voffB[2];
#pragma unroll
    for (int i = 0; i < 2; ++i) { int R, C; stage_rc(tid * 16 + i * 8192, R, C); const int Rb = Epi::PERM ? ((R & ~31) + perm32(R & 31)) : R;
        voffA[i] = (unsigned)(R * S.lda + C) * 2u; voffB[i] = (unsigned)(Rb * S.ldb + C) * 2u; }
    const size_t kstep = (size_t)(BK * 2);
    const size_t hstepA = (size_t)HALF * S.lda * 2, hstepB = (size_t)HALF * S.ldb * 2;
    const unsigned ldsw = (unsigned)wid * 1024u;
    const int aoff = lds_byte(wr * 64 + fr, fq * 8), boff = lds_byte(wc * 32 + fr, fq * 8);
#define PG8_SA(b, h) (((b) * 2 + (h)) * HTB)
#define PG8_SB(b, h) ((4 + (b) * 2 + (h)) * HTB)
#define PG8_STAGE(bufoff, gbase, voff) do { _Pragma("unroll") for (int _i = 0; _i < 2; ++_i) \
        __builtin_amdgcn_global_load_lds((const unsigned*)((const char*)(gbase) + (voff)[_i]), (LAS unsigned*)(lds + (bufoff) + ldsw + _i * 8192), 16, 0, 0); } while (0)
#define PG8_LDA(dst, b, h) do { _Pragma("unroll") for (int m = 0; m < 4; ++m) _Pragma("unroll") for (int k = 0; k < 2; ++k) dst[m][k] = *(const LAS bf16x8*)(lds + PG8_SA(b, h) + aoff + m * 2048 + k * 1024); } while (0)
#define PG8_LDB(dst, b, h) do { _Pragma("unroll") for (int n = 0; n < 2; ++n) _Pragma("unroll") for (int k = 0; k < 2; ++k) dst[n][k] = *(const LAS bf16x8*)(lds + PG8_SB(b, h) + boff + n * 2048 + k * 1024); } while (0)
#define PG8_MMA(ai, bj, At, Bt) do { __builtin_amdgcn_s_setprio(1); _Pragma("unroll") for (int m = 0; m < 4; ++m) _Pragma("unroll") for (int n = 0; n < 2; ++n) _Pragma("unroll") for (int k = 0; k < 2; ++k) \
        acc[ai][bj][m][n] = __builtin_amdgcn_mfma_f32_16x16x32_bf16(Bt[n][k], At[m][k], acc[ai][bj][m][n], 0, 0, 0); __builtin_amdgcn_s_setprio(0); } while (0)
#define PG8_WAIT_V(n) asm volatile("s_waitcnt vmcnt(" #n ")" ::: "memory")
#define PG8_WAIT_L(n) asm volatile("s_waitcnt lgkmcnt(" #n ")" ::: "memory")
#define PG8_BAR __builtin_amdgcn_s_barrier()
#define PG8_SCHED __builtin_amdgcn_sched_barrier(0)
    Unit cur, nxt; int ui = 0;
    if (!S.next(0, cur)) return;
    f32x4 acc[2][2][4][2];
#pragma unroll
    for (int a = 0; a < 2; ++a)
#pragma unroll
        for (int b = 0; b < 2; ++b)
#pragma unroll
            for (int m = 0; m < 4; ++m)
#pragma unroll
                for (int n = 0; n < 2; ++n) acc[a][b][m][n] = (f32x4){0.f, 0.f, 0.f, 0.f};
    bf16x8 At[4][2], B0[2][2], B1[2][2];
    const char* cA = S.a_ptr(cur); const char* cB = S.b_ptr(cur);
    if constexpr (SP2) {
        PG8_STAGE(PG8_SB(0, 0), cB, voffB); PG8_STAGE(PG8_SB(0, 1), cB + hstepB, voffB); PG8_STAGE(PG8_SA(0, 0), cA, voffA); PG8_STAGE(PG8_SA(0, 1), cA + hstepA, voffA);
        if (wr == 1) PG8_BAR;
        PG8_WAIT_V(2); PG8_BAR;
        PG8_STAGE(PG8_SB(1, 0), cB + kstep, voffB); PG8_STAGE(PG8_SA(1, 0), cA + kstep, voffA); PG8_STAGE(PG8_SB(1, 1), cB + hstepB + kstep, voffB);
        PG8_WAIT_V(6); PG8_BAR;
    } else {
        PG8_STAGE(PG8_SB(0, 0), cB, voffB); PG8_STAGE(PG8_SA(0, 0), cA, voffA); PG8_STAGE(PG8_SB(0, 1), cB + hstepB, voffB); PG8_STAGE(PG8_SA(0, 1), cA + hstepA, voffA);
        if (wr == 1) PG8_BAR;
        PG8_WAIT_V(4); PG8_BAR;
        PG8_STAGE(PG8_SB(1, 0), cB + kstep, voffB); PG8_STAGE(PG8_SA(1, 0), cA + kstep, voffA); PG8_STAGE(PG8_SB(1, 1), cB + hstepB + kstep, voffB);
        PG8_WAIT_V(6); PG8_BAR;
    }
    for (;;) {
        const bool has_next = S.next(ui + 1, nxt);
        const char* nA = has_next ? S.a_ptr(nxt) : cA; const char* nB = has_next ? S.b_ptr(nxt) : cB;
        for (int t = 0; t < nt; t += 2) {
            const bool last = (t == nt - 2);
            const char* a1 = cA + (size_t)(t + 1) * kstep;
            const char* a2 = last ? nA : cA + (size_t)(t + 2) * kstep; const char* b2 = last ? nB : cB + (size_t)(t + 2) * kstep;
            const char* a3 = a2 + kstep; const char* b3 = b2 + kstep;
            if constexpr (SP2) {
            PG8_LDB(B0, 0, 0); PG8_LDB(B1, 0, 1); PG8_SCHED; PG8_LDA(At, 0, 0); PG8_STAGE(PG8_SA(1, 1), a1 + hstepA, voffA);
            PG8_WAIT_V(8); PG8_WAIT_L(0); PG8_BAR; PG8_MMA(0, 0, At, B0); PG8_MMA(0, 1, At, B1); PG8_BAR; PG8_SCHED;
            PG8_LDA(At, 0, 1); PG8_STAGE(PG8_SB(0, 0), b2, voffB); PG8_STAGE(PG8_SB(0, 1), b2 + hstepB, voffB); PG8_STAGE(PG8_SA(0, 0), a2, voffA);
            PG8_WAIT_V(8); PG8_WAIT_L(0); PG8_BAR; PG8_MMA(1, 0, At, B0); PG8_MMA(1, 1, At, B1); PG8_BAR; PG8_SCHED;
            PG8_LDB(B0, 1, 0); PG8_LDB(B1, 1, 1); PG8_SCHED; PG8_LDA(At, 1, 0); PG8_STAGE(PG8_SA(0, 1), a2 + hstepA, voffA);
            PG8_WAIT_V(8); PG8_WAIT_L(0); PG8_BAR; PG8_MMA(0, 0, At, B0); PG8_MMA(0, 1, At, B1); PG8_BAR; PG8_SCHED;
            PG8_LDA(At, 1, 1); PG8_STAGE(PG8_SB(1, 0), b3, voffB); PG8_STAGE(PG8_SB(1, 1), b3 + hstepB, voffB); PG8_STAGE(PG8_SA(1, 0), a3, voffA);
            PG8_WAIT_V(8); PG8_WAIT_L(0); PG8_BAR; PG8_MMA(1, 0, At, B0); PG8_MMA(1, 1, At, B1); PG8_BAR; PG8_SCHED;
            } else {
            PG8_LDB(B0, 0, 0); PG8_SCHED; PG8_LDA(At, 0, 0); PG8_STAGE(PG8_SA(1, 1), a1 + hstepA, voffA);
            PG8_WAIT_L(8); PG8_BAR; PG8_WAIT_L(0); PG8_MMA(0, 0, At, B0); PG8_BAR; PG8_SCHED;
            PG8_LDB(B1, 0, 1); PG8_STAGE(PG8_SB(0, 0), b2, voffB);
            PG8_BAR; PG8_WAIT_L(0); PG8_MMA(0, 1, At, B1); PG8_BAR;
            PG8_LDA(At, 0, 1); PG8_STAGE(PG8_SA(0, 0), a2, voffA);
            PG8_BAR; PG8_WAIT_L(0); PG8_MMA(1, 0, At, B0); PG8_BAR; PG8_SCHED;
            PG8_STAGE(PG8_SB(0, 1), b2 + hstepB, voffB);
            PG8_WAIT_V(6); PG8_BAR; PG8_MMA(1, 1, At, B1); PG8_BAR;
            PG8_LDB(B0, 1, 0); PG8_SCHED; PG8_LDA(At, 1, 0); PG8_STAGE(PG8_SA(0, 1), a2 + hstepA, voffA);
            PG8_WAIT_L(8); PG8_BAR; PG8_WAIT_L(0); PG8_MMA(0, 0, At, B0); PG8_BAR; PG8_SCHED;
            PG8_LDB(B1, 1, 1); PG8_STAGE(PG8_SB(1, 0), b3, voffB);
            PG8_BAR; PG8_WAIT_L(0); PG8_MMA(0, 1, At, B1); PG8_BAR;
            PG8_LDA(At, 1, 1); PG8_STAGE(PG8_SA(1, 0), a3, voffA);
            PG8_BAR; PG8_WAIT_L(0); PG8_MMA(1, 0, At, B0); PG8_BAR; PG8_SCHED;
            PG8_STAGE(PG8_SB(1, 1), b3 + hstepB, voffB);
            PG8_WAIT_V(6); PG8_BAR; PG8_MMA(1, 1, At, B1); PG8_BAR;
            }
        }
        if constexpr (ALIGN_EPI) { if (wr == 0) PG8_BAR; }
        E(acc, cur, wr, wc, fr, fq, lds);
        if (!has_next) break;
#pragma unroll
        for (int a = 0; a < 2; ++a)
#pragma unroll
            for (int b = 0; b < 2; ++b)
#pragma unroll
                for (int m = 0; m < 4; ++m)
#pragma unroll
                    for (int n = 0; n < 2; ++n) acc[a][b][m][n] = (f32x4){0.f, 0.f, 0.f, 0.f};
        cur = nxt; cA = nA; cB = nB; ++ui;
        if constexpr (ALIGN_EPI) { if (wr == 1) PG8_BAR; }
    }
    PG8_WAIT_V(0);
    if constexpr (!ALIGN_EPI) { if (wr == 0) PG8_BAR; }
    PG8_BAR;
#undef PG8_SA
#undef PG8_SB
#undef PG8_STAGE
#undef PG8_LDA
#undef PG8_LDB
#undef PG8_MMA
#undef PG8_WAIT_V
#undef PG8_WAIT_L
#undef PG8_BAR
#undef PG8_SCHED
}
}

#ifndef PG8_SP2
#define PG8_SP2 true
#endif

struct TDesc { const float* W; bf16_t* WT; int K, N, row_off, item, scaled; };
__device__ __forceinline__ void p0_item_load(const TDesc& d, f32x4 (&v)[16], int lane) {
    const int nblk = d.N / 64, kb = d.item / nblk, nb = d.item % nblk, k0 = 64 * kb, n0 = 64 * nb;
    const int nn = (lane & 15) * 4;
#pragma unroll
    for (int i = 0; i < 16; ++i) { const int kk = 4 * i + (lane >> 4); v[i] = __builtin_nontemporal_load((const f32x4*)(d.W + (size_t)(k0 + kk) * d.N + n0 + nn)); }
}
__device__ __forceinline__ void p0_item_store(const TDesc& d, const f32x4 (&v)[16], LAS float* scr, int lane, const float* gs, const float* bs, float* c1, float* c2) {
    const int nblk = d.N / 64, kb = d.item / nblk, nb = d.item % nblk, k0 = 64 * kb, n0 = 64 * nb;
    const int nn = (lane & 15) * 4;
#pragma unroll
    for (int i = 0; i < 16; ++i) { const int kk = 4 * i + (lane >> 4); LAS float* q = scr + kk * 65 + nn; q[0] = v[i][0]; q[1] = v[i][1]; q[2] = v[i][2]; q[3] = v[i][3]; }
    asm volatile("s_waitcnt lgkmcnt(0)" ::: "memory");
    const int c = lane & 7;
    if (d.scaled) {
        const f32x4 ga = *(const f32x4*)(gs + k0 + 8 * c), gb = *(const f32x4*)(gs + k0 + 8 * c + 4), ba = *(const f32x4*)(bs + k0 + 8 * c), bb = *(const f32x4*)(bs + k0 + 8 * c + 4);
#pragma unroll
        for (int j = 0; j < 8; ++j) { const int n = (lane >> 3) + 8 * j; const LAS float* sp = scr + (8 * c) * 65 + n;
            const float w0 = sp[0 * 65], w1 = sp[1 * 65], w2 = sp[2 * 65], w3 = sp[3 * 65], w4 = sp[4 * 65], w5 = sp[5 * 65], w6 = sp[6 * 65], w7 = sp[7 * 65];
            u32x4 o; o.x = cvt_pk_bf16(w0 * ga[0], w1 * ga[1]); o.y = cvt_pk_bf16(w2 * ga[2], w3 * ga[3]); o.z = cvt_pk_bf16(w4 * gb[0], w5 * gb[1]); o.w = cvt_pk_bf16(w6 * gb[2], w7 * gb[3]);
            float s1 = ((bf_lo(o.x) + bf_hi(o.x)) + (bf_lo(o.y) + bf_hi(o.y))) + ((bf_lo(o.z) + bf_hi(o.z)) + (bf_lo(o.w) + bf_hi(o.w)));
            float s2 = ((w0 * ba[0] + w1 * ba[1]) + (w2 * ba[2] + w3 * ba[3])) + ((w4 * bb[0] + w5 * bb[1]) + (w6 * bb[2] + w7 * bb[3]));
            s1 += __shfl_xor(s1, 1); s1 += __shfl_xor(s1, 2); s1 += __shfl_xor(s1, 4); s2 += __shfl_xor(s2, 1); s2 += __shfl_xor(s2, 2); s2 += __shfl_xor(s2, 4);
            if (c == 0) { __hip_atomic_fetch_add(c1 + n0 + n, s1, __ATOMIC_RELAXED, __HIP_MEMORY_SCOPE_AGENT); __hip_atomic_fetch_add(c2 + n0 + n, s2, __ATOMIC_RELAXED, __HIP_MEMORY_SCOPE_AGENT); }
            *(u32x4*)(d.WT + (size_t)(d.row_off + n0 + n) * d.K + k0 + 8 * c) = o; }
    } else {
#pragma unroll
        for (int j = 0; j < 8; ++j) { const int n = (lane >> 3) + 8 * j; const LAS float* sp = scr + (8 * c) * 65 + n;
            u32x4 o; o.x = cvt_pk_bf16(sp[0 * 65], sp[1 * 65]); o.y = cvt_pk_bf16(sp[2 * 65], sp[3 * 65]); o.z = cvt_pk_bf16(sp[4 * 65], sp[5 * 65]); o.w = cvt_pk_bf16(sp[6 * 65], sp[7 * 65]);
            *(u32x4*)(d.WT + (size_t)(d.row_off + n0 + n) * d.K + k0 + 8 * c) = o; }
    }
    asm volatile("s_waitcnt lgkmcnt(0)" ::: "memory");
}

__device__ __forceinline__ void ln_rows_folded(const bf16_t* Z, const float* stats, const float* g2, const float* b2, const bf16_t* Y, float* O, const float* g, const float* b, int gw, int NGW, int lane) {
    for (int row = gw; row < T; row += NGW) {
        const f32x2 st = *(const f32x2*)(stats + 2 * (size_t)row);
        const float mean2 = st.x * (1.0f / D); const float rstd2 = 1.0f / sqrtf(fmaxf(st.y * (1.0f / D) - mean2 * mean2, 0.f) + LN_EPS);
        f32x4 v[8]; float s = 0.f;
#pragma unroll
        for (int j = 0; j < 8; ++j) {
            const u32x2 zw = *(const u32x2*)(Z + (size_t)row * D + 4 * lane + 256 * j); const u32x2 y = *(const u32x2*)(Y + (size_t)row * D + 4 * lane + 256 * j);
            const f32x4 g4 = *(const f32x4*)(g2 + 4 * lane + 256 * j), b4 = *(const f32x4*)(b2 + 4 * lane + 256 * j);
            const f32x4 z = {bf_lo(zw.x), bf_hi(zw.x), bf_lo(zw.y), bf_hi(zw.y)}; const f32x4 yy = {bf_lo(y.x), bf_hi(y.x), bf_lo(y.y), bf_hi(y.y)};
            v[j] = ((z - mean2) * rstd2 * g4 + b4) * ALPHA + yy;
            s += (v[j][0] + v[j][1]) + (v[j][2] + v[j][3]); }
        const float mean = wave_sum(s) * (1.0f / D); float s2 = 0.f;
#pragma unroll
        for (int j = 0; j < 8; ++j) { v[j] = v[j] - mean; s2 += (v[j][0] * v[j][0] + v[j][1] * v[j][1]) + (v[j][2] * v[j][2] + v[j][3] * v[j][3]); }
        const float rstd = 1.0f / sqrtf(wave_sum(s2) * (1.0f / D) + LN_EPS);
#pragma unroll
        for (int j = 0; j < 8; ++j) { const f32x4 g4 = *(const f32x4*)(g + 4 * lane + 256 * j), b4 = *(const f32x4*)(b + 4 * lane + 256 * j);
            __builtin_nontemporal_store(v[j] * rstd * g4 + b4, (f32x4*)(O + (size_t)row * D + 4 * lane + 256 * j)); }
    }
}
template <bool RBF>
__device__ __forceinline__ void ln_rows(const void* Rv, const bf16_t* Y, float* O, const float* g, const float* b, bf16_t* XBo, int gw, int NGW, int lane) {
    for (int row = gw; row < T; row += NGW) {
        const bf16_t* yr = Y + (size_t)row * D + 4 * lane;
        f32x4 v[8]; float s = 0.f;
#pragma unroll
        for (int j = 0; j < 8; ++j) {
            f32x4 r;
            if constexpr (RBF) { const u32x2 rw = *(const u32x2*)((const bf16_t*)Rv + (size_t)row * D + 4 * lane + 256 * j); r[0] = bf_lo(rw.x); r[1] = bf_hi(rw.x); r[2] = bf_lo(rw.y); r[3] = bf_hi(rw.y); }
            else r = __builtin_nontemporal_load((const f32x4*)((const float*)Rv + (size_t)row * D + 4 * lane + 256 * j));
            const u32x2 y = *(const u32x2*)(yr + 256 * j);
            v[j][0] = r[0] * ALPHA + bf_lo(y.x); v[j][1] = r[1] * ALPHA + bf_hi(y.x); v[j][2] = r[2] * ALPHA + bf_lo(y.y); v[j][3] = r[3] * ALPHA + bf_hi(y.y);
            s += (v[j][0] + v[j][1]) + (v[j][2] + v[j][3]); }
        const float mean = wave_sum(s) * (1.0f / D); float s2 = 0.f;
#pragma unroll
        for (int j = 0; j < 8; ++j) { v[j] = v[j] - mean; s2 += (v[j][0] * v[j][0] + v[j][1] * v[j][1]) + (v[j][2] * v[j][2] + v[j][3] * v[j][3]); }
        const float rstd = 1.0f / sqrtf(wave_sum(s2) * (1.0f / D) + LN_EPS);
#pragma unroll
        for (int j = 0; j < 8; ++j) { const f32x4 g4 = *(const f32x4*)(g + 4 * lane + 256 * j), b4 = *(const f32x4*)(b + 4 * lane + 256 * j);
            const f32x4 y = v[j] * rstd * g4 + b4;
            if (O) __builtin_nontemporal_store(y, (f32x4*)(O + (size_t)row * D + 4 * lane + 256 * j));
            if (XBo) { u32x2 w; w.x = cvt_pk_bf16(y[0], y[1]); w.y = cvt_pk_bf16(y[2], y[3]); *(u32x2*)(XBo + (size_t)row * D + 4 * lane + 256 * j) = w; } }
    }
}

#define XB_TMO      128
#define XB_XCNT(j)  (256  + 64 * (j))
#define XB_XSUB(j)  (1280 + 64 * (j))
#define XB_XGEN(j)  (2304 + 64 * (j))
#define XB_TOP      3328
#define XB_TOPGEN   3392
#define XCD_BAR_WORDS 3456
#define XB_SPIN_CAP (1u << 18)
__device__ __forceinline__ unsigned xb_ld(unsigned* p)              { return __hip_atomic_load(p, __ATOMIC_RELAXED, __HIP_MEMORY_SCOPE_AGENT); }
__device__ __forceinline__ unsigned xb_add(unsigned* p, unsigned v) { return __hip_atomic_fetch_add(p, v, __ATOMIC_RELAXED, __HIP_MEMORY_SCOPE_AGENT); }
__device__ __forceinline__ unsigned xb_xcc_id() { return (unsigned)__builtin_amdgcn_s_getreg((3 << 11) | 20) & 0xFu; }
#define XB_SPIN(cond, bar) do { unsigned _sp = 0; while (cond) { __builtin_amdgcn_s_sleep(1); \
    if ((++_sp & 255u) == 0u) { if (xb_ld(&(bar)[XB_TMO])) break; if (_sp > XB_SPIN_CAP) { atomicAdd(&(bar)[XB_TMO], 1u); break; } } } } while (0)
struct XcdBarrier { unsigned* bar; unsigned x; volatile LAS unsigned* st; };
__device__ __forceinline__ XcdBarrier xcd_barrier_post(unsigned* bar, volatile LAS unsigned* st) {
    XcdBarrier b; b.bar = bar; b.x = xb_xcc_id(); b.st = st;
    if (threadIdx.x == 0) (void)xb_add(&bar[XB_XCNT(b.x)], 1u);
    return b;
}
__device__ __forceinline__ void xcd_barrier_complete(unsigned* bar, unsigned x, unsigned& nloc, unsigned& nx) {
    const unsigned G = gridDim.x * gridDim.y * gridDim.z;
    unsigned sum, cnt, mine, sp = 0u;
    for (;;) {
        sum = 0u; cnt = 0u; mine = 0u;
#pragma unroll
        for (unsigned j = 0; j < 16; ++j) { const unsigned c = xb_ld(&bar[XB_XCNT(j)]); sum += c; cnt += (c > 0u) ? 1u : 0u; mine = (j == x) ? c : mine; }
        if (sum == G) break;
        __builtin_amdgcn_s_sleep(1);
        if ((++sp & 255u) == 0u) { if (xb_ld(&bar[XB_TMO])) break; if (sp > XB_SPIN_CAP) { atomicAdd(&bar[XB_TMO], 1u); break; } }
    }
    nloc = mine > 0u ? mine : 1u; nx = cnt > 0u ? cnt : 1u;
}
__device__ __forceinline__ void xcd_barrier(const XcdBarrier& b) {
    asm volatile("s_waitcnt vmcnt(0)" ::: "memory");
    __syncthreads();
    if (threadIdx.x == 0) {
        unsigned* bar = b.bar;
        __builtin_amdgcn_s_waitcnt(0);
        unsigned nloc = b.st[0], nx = b.st[1];
        if (nloc == 0u) { xcd_barrier_complete(bar, b.x, nloc, nx); b.st[0] = nloc; b.st[1] = nx; }
        const unsigned old = xb_add(&bar[XB_XSUB(b.x)], 1u);
        const unsigned gen = old / nloc;
        if (old + 1u == (gen + 1u) * nloc) {
            __builtin_amdgcn_fence(__ATOMIC_RELEASE, "agent");
            asm volatile("s_waitcnt vmcnt(0)" ::: "memory");
            const unsigned og = xb_add(&bar[XB_TOP], 1u);
            const unsigned tg = og / nx;
            if (og + 1u == (tg + 1u) * nx) xb_add(&bar[XB_TOPGEN], 1u);
            else XB_SPIN(xb_ld(&bar[XB_TOPGEN]) == tg, bar);
            __builtin_amdgcn_fence(__ATOMIC_ACQUIRE, "agent");
            xb_add(&bar[XB_XGEN(b.x)], 1u);
            asm volatile("s_waitcnt vmcnt(0)" ::: "memory");
        } else {
            XB_SPIN(xb_ld(&bar[XB_XGEN(b.x)]) == gen, bar);
            __builtin_amdgcn_fence(__ATOMIC_ACQUIRE, "agent");
            asm volatile("s_waitcnt vmcnt(0)" ::: "memory");
        }
    }
    __syncthreads();
}

struct Args { const float* in[26]; float* out; unsigned char* ws; int ph_lo, ph_hi; };
constexpr int N_PHASES = 15;

__global__ void __launch_bounds__(512, 2) fwd_mega(Args args) {
    extern __shared__ __attribute__((aligned(16))) unsigned char lds_raw[];
    LAS unsigned char* lds = (LAS unsigned char*)lds_raw;
    const int G = gridDim.x, bid = blockIdx.x;
    const int NGW = G * 8; const long NGT = (long)G * 512;
#define PHASE_IDS() int tid = threadIdx.x; asm volatile("" : "+v"(tid)); const int lane = tid & 63, wave = __builtin_amdgcn_readfirstlane(tid >> 6); \
    const int gw = bid * 8 + wave; const long gt = (long)bid * 512 + tid; (void)lane; (void)gw; (void)gt;
    unsigned char* ws = args.ws;
    const float* x = args.in[0]; const float* mem = args.in[1];
    bf16_t* WIN = (bf16_t*)(ws + WS_WIN); bf16_t* WOUT = (bf16_t*)(ws + WS_WOUT); bf16_t* WQ = (bf16_t*)(ws + WS_WQ); bf16_t* WK = (bf16_t*)(ws + WS_WK);
    bf16_t* WV = (bf16_t*)(ws + WS_WV); bf16_t* WO = (bf16_t*)(ws + WS_WO); bf16_t* WFF1 = (bf16_t*)(ws + WS_WFF1); bf16_t* WFF2 = (bf16_t*)(ws + WS_WFF2);
    bf16_t* WPOOL = (bf16_t*)(ws + WS_WPOOL); bf16_t* WAX = (bf16_t*)(ws + WS_WAX);
    bf16_t* MEMB = (bf16_t*)(ws + WS_MEMB); bf16_t* KB = (bf16_t*)(ws + WS_KB); bf16_t* VT = (bf16_t*)(ws + WS_VT);
    bf16_t* XB = (bf16_t*)(ws + WS_XB); unsigned short* BH = (unsigned short*)(ws + WS_BF); bf16_t* PROJ = (bf16_t*)(ws + WS_PROJ); bf16_t* Y3 = (bf16_t*)(ws + WS_Y3); bf16_t* QB = (bf16_t*)(ws + WS_Q); bf16_t* YB = (bf16_t*)(ws + WS_Q);
    bf16_t* PB = (bf16_t*)(ws + WS_PB); bf16_t* A2 = (bf16_t*)(ws + WS_A2); float* SUMP = (float*)(ws + WS_SUM); float* SUMH = SUMP + 4 * 64 * 1024;
    bf16_t* OB = (bf16_t*)(ws + WS_O); bf16_t* MIX = (bf16_t*)(ws + WS_MIX); unsigned short* AH = (unsigned short*)(ws + WS_AF); bf16_t* HB = (bf16_t*)(ws + WS_H);
    float* out = args.out;
    float* C1 = (float*)(ws + WS_CTL + CTL_C1); float* C2 = (float*)(ws + WS_CTL + CTL_C2); float* STATS2 = (float*)(ws + WS_CTL + CTL_STATS2);
    const int lo = args.ph_lo, hi = args.ph_hi;
#define IN(k) (lo <= (k) && (k) < hi)
#define SEAM(k) do { if (IN(k) && IN((k) + 1)) { xcd_barrier(bar); } } while (0)
    volatile LAS unsigned* bst = (volatile LAS unsigned*)(lds + LDS_BARST);
    if (threadIdx.x < 4) bst[threadIdx.x] = 0u;
    __syncthreads();
    XcdBarrier bar = xcd_barrier_post((unsigned*)(ws + WS_CTL) + 4096, bst);
    if (lo < -1) cg::this_grid().sync();

    if (IN(0)) for (int rep_ = 0; rep_ <= ((PROBE_DUP_MASK >> 0) & 1); ++rep_) {
        PHASE_IDS();
        LAS float* scr = (LAS float*)(lds + wave * 16640);
        constexpr int I_IN = 32 * 48, I_SQ = 32 * 32, I_F1 = 32 * 128, I_F2 = 128 * 32, I_POOL = 4 * 16, I_AX = 16 * 4;
        constexpr int NIT = I_IN + 5 * I_SQ + I_F1 + I_F2 + I_POOL + I_AX;
#define P0_RESOLVE(it_, d_) do { int r = (it_); \
            if (r < I_F1) { d_ = TDesc{args.in[22], WFF1, D, DFF, 0, r, 1}; break; } r -= I_F1; \
            if (r < I_F2) { d_ = TDesc{args.in[23], WFF2, DFF, D, 0, r, 0}; break; } r -= I_F2; \
            if (r < I_IN) { d_ = TDesc{args.in[2], WIN, D, NPROJ, 0, r, 0}; break; } r -= I_IN; \
            if (r < I_SQ) { d_ = TDesc{args.in[13], WOUT, D, D, 0, r, 0}; break; } r -= I_SQ; \
            if (r < I_SQ) { d_ = TDesc{args.in[16], WQ, D, D, 0, r, 0}; break; } r -= I_SQ; \
            if (r < I_SQ) { d_ = TDesc{args.in[17], WK, D, D, 0, r, 0}; break; } r -= I_SQ; \
            if (r < I_SQ) { d_ = TDesc{args.in[18], WV, D, D, 0, r, 0}; break; } r -= I_SQ; \
            if (r < I_SQ) { d_ = TDesc{args.in[19], WO, D, D, 0, r, 0}; break; } r -= I_SQ; \
            if (r < I_POOL) { const int g = r >> 4; d_ = TDesc{args.in[10] + (size_t)g * 65536, WPOOL + (size_t)g * 65536, 256, 256, 0, r & 15, 0}; break; } r -= I_POOL; \
            { const int mtx = r >> 2, h = mtx >> 1, which = mtx & 1;       \
              d_ = TDesc{args.in[which ? 7 : 5] + (size_t)h * 16384, WAX + (size_t)h * 32768, 128, 128, which * 128, r & 3, 0}; } } while (0)
        if (gw < NIT) {
            TDesc dc, dn; f32x4 vc[16], vn[16];
            P0_RESOLVE(gw, dc); p0_item_load(dc, vc, lane);
            for (int it = gw;;) {
                const int itn = it + NGW; const bool has_next = itn < NIT;
                if (has_next) { P0_RESOLVE(itn, dn); p0_item_load(dn, vn, lane); }
                p0_item_store(dc, vc, scr, lane, args.in[20], args.in[21], C1, C2);
                if (!has_next) break;
                dc = dn; it = itn;
#pragma unroll
                for (int i = 0; i < 16; ++i) vc[i] = vn[i];
            }
        }
#undef P0_RESOLVE
#pragma unroll 4
        for (long i = gt; i < (long)T * D / 8; i += NGT) { const f32x4 a = __builtin_nontemporal_load((const f32x4*)(x + i * 8)), b = __builtin_nontemporal_load((const f32x4*)(x + i * 8 + 4));
            u32x4 w; w.x = cvt_pk_bf16(a[0], a[1]); w.y = cvt_pk_bf16(a[2], a[3]); w.z = cvt_pk_bf16(b[0], b[1]); w.w = cvt_pk_bf16(b[2], b[3]); *(u32x4*)(XB + i * 8) = w; }
        for (long i = gt; i < (long)NMEMROWS * D / 8; i += NGT) { const f32x4 a = *(const f32x4*)(mem + i * 8), b = *(const f32x4*)(mem + i * 8 + 4);
            u32x4 w; w.x = cvt_pk_bf16(a[0], a[1]); w.y = cvt_pk_bf16(a[2], a[3]); w.z = cvt_pk_bf16(b[0], b[1]); w.w = cvt_pk_bf16(b[2], b[3]); *(u32x4*)(MEMB + i * 8) = w; }
        __syncthreads();
    }
    SEAM(0);

    if (IN(1)) for (int rep_ = 0; rep_ <= ((PROBE_DUP_MASK >> 1) & 1); ++rep_) {
        { pg8::GSched S; S.init(XB, D, WIN, D, 1, 64, 12, G, bid); pg8::EpiBf16 E{PROJ, NPROJ, 0, 0, 1, 0};
          pg8::gemm_phase<pg8::EpiBf16, pg8::GSched, true, PG8_SP2>(lds, D, S, E); }
    }
    SEAM(1);

    if (IN(2)) for (int rep_ = 0; rep_ <= ((PROBE_DUP_MASK >> 2) & 1); ++rep_) {
        PHASE_IDS();
        const float* conv_w = args.in[3]; const float* conv_b = args.in[4];
        for (long it = gt; it < (long)(T / 32) * 256; it += NGT) {
            const int chunk = (int)(it & 255), r0 = (int)(it >> 8) * 32, pos0 = r0 & (SEQ - 1);
            if (chunk < 128) {
                const int g = chunk >> 5, w = 2 << g;
                const bf16_t* p = PROJ + (size_t)r0 * NPROJ + chunk * 8;
                float s[8];
#pragma unroll
                for (int j = 0; j < 8; ++j) s[j] = 0.f;
                for (int k = 1; k < w; ++k) { if (pos0 - k >= 0) { const u32x4 v = *(const u32x4*)(p - (size_t)k * NPROJ);
                    s[0] += bf_lo(v.x); s[1] += bf_hi(v.x); s[2] += bf_lo(v.y); s[3] += bf_hi(v.y); s[4] += bf_lo(v.z); s[5] += bf_hi(v.z); s[6] += bf_lo(v.w); s[7] += bf_hi(v.w); } }
#pragma unroll 8
                for (int t = 0; t < 32; ++t) {
                    const int pos = pos0 + t;
                    const u32x4 v = *(const u32x4*)(p + (size_t)t * NPROJ);
                    const float u[8] = {bf_lo(v.x), bf_hi(v.x), bf_lo(v.y), bf_hi(v.y), bf_lo(v.z), bf_hi(v.z), bf_lo(v.w), bf_hi(v.w)};
#pragma unroll
                    for (int j = 0; j < 8; ++j) s[j] += u[j];
                    const int cnt = (pos + 1) < w ? (pos + 1) : w; const float inv = 1.0f / (float)cnt;
                    u32x4 o; o.x = cvt_pk_bf16(s[0] * inv - u[0], s[1] * inv - u[1]); o.y = cvt_pk_bf16(s[2] * inv - u[2], s[3] * inv - u[3]);
                    o.z = cvt_pk_bf16(s[4] * inv - u[4], s[5] * inv - u[5]); o.w = cvt_pk_bf16(s[6] * inv - u[6], s[7] * inv - u[7]);
                    *(u32x4*)(A2 + (size_t)(r0 + t) * D + chunk * 8) = o;
                    if (pos + 1 - w >= 0) { const u32x4 q = *(const u32x4*)(p + ((long)t + 1 - w) * NPROJ);
                        s[0] -= bf_lo(q.x); s[1] -= bf_hi(q.x); s[2] -= bf_lo(q.y); s[3] -= bf_hi(q.y); s[4] -= bf_lo(q.z); s[5] -= bf_hi(q.z); s[6] -= bf_lo(q.w); s[7] -= bf_hi(q.w); }
                }
            } else {
                const int c = (chunk - 128) * 8;
                const bf16_t* p = PROJ + (size_t)r0 * NPROJ + 1024 + c;
                float cw[4][8], cb[8];
#pragma unroll
                for (int k = 0; k < 4; ++k) { const f32x4 w0 = *(const f32x4*)(conv_w + k * 1024 + c), w1 = *(const f32x4*)(conv_w + k * 1024 + c + 4);
                    cw[k][0] = w0[0]; cw[k][1] = w0[1]; cw[k][2] = w0[2]; cw[k][3] = w0[3]; cw[k][4] = w1[0]; cw[k][5] = w1[1]; cw[k][6] = w1[2]; cw[k][7] = w1[3]; }
                { const f32x4 b0 = *(const f32x4*)(conv_b + c), b1 = *(const f32x4*)(conv_b + c + 4); cb[0] = b0[0]; cb[1] = b0[1]; cb[2] = b0[2]; cb[3] = b0[3]; cb[4] = b1[0]; cb[5] = b1[1]; cb[6] = b1[2]; cb[7] = b1[3]; }
                const u32x4 zero = {0u, 0u, 0u, 0u};
                u32x4 v0 = zero, v1 = zero, v2 = zero;
                if (pos0 > 0) { v0 = *(const u32x4*)(p - 3 * (size_t)NPROJ); v1 = *(const u32x4*)(p - 2 * (size_t)NPROJ); v2 = *(const u32x4*)(p - (size_t)NPROJ); }
#pragma unroll 8
                for (int t = 0; t < 32; ++t) {
                    const u32x4 v3 = *(const u32x4*)(p + (size_t)t * NPROJ);
                    float s[8];
#pragma unroll
                    for (int j = 0; j < 8; ++j) s[j] = cb[j];
#define CONV_TAP(k, v) s[0] += cw[k][0] * bf_lo(v.x); s[1] += cw[k][1] * bf_hi(v.x); s[2] += cw[k][2] * bf_lo(v.y); s[3] += cw[k][3] * bf_hi(v.y); \
                       s[4] += cw[k][4] * bf_lo(v.z); s[5] += cw[k][5] * bf_hi(v.z); s[6] += cw[k][6] * bf_lo(v.w); s[7] += cw[k][7] * bf_hi(v.w);
                    CONV_TAP(0, v0) CONV_TAP(1, v1) CONV_TAP(2, v2) CONV_TAP(3, v3)
#undef CONV_TAP
                    u32x4 o; o.x = cvt_pk_bf16(s[0], s[1]); o.y = cvt_pk_bf16(s[2], s[3]); o.z = cvt_pk_bf16(s[4], s[5]); o.w = cvt_pk_bf16(s[6], s[7]);
                    *(u32x4*)(A2 + (size_t)(r0 + t) * D + 1024 + c) = o;
                    v0 = v1; v1 = v2; v2 = v3;
                }
            }
        }
    }
    SEAM(2);

    if (IN(3)) for (int rep_ = 0; rep_ <= ((PROBE_DUP_MASK >> 3) & 1); ++rep_) {
        if (bid < 32) { pg8::GSched S; S.init(MEMB, D, WK, D, 1, 4, 8, 32, bid); pg8::EpiBf16 E{KB, D, 0, 0, 1, 0};
          pg8::gemm_phase<pg8::EpiBf16, pg8::GSched, true, PG8_SP2>(lds, D, S, E); }
        else if (bid < 64) { pg8::GSched S; S.init(WV, D, MEMB, D, 1, 8, 4, 32, bid - 32); pg8::EpiBf16 E{VT, NMEMROWS, 0, 0, 1, 0};
          pg8::gemm_phase<pg8::EpiBf16, pg8::GSched, true, PG8_SP2>(lds, D, S, E); }
        else {
        const int G2 = G - 64, c2 = bid - 64;
        { pg8::GSched S; S.init(A2, D, WPOOL, 256, 4, 64, 1, G2, c2); S.ga1 = 256; S.gb1 = 65536; pg8::EpiPool E{MIX, args.in[11], args.in[12]};
          pg8::gemm_phase<pg8::EpiPool, pg8::GSched, true, PG8_SP2>(lds, 256, S, E); }
        { pg8::GSched S; S.init(A2 + 1024, D, WAX, 128, 8, 64, 1, G2, (c2 + 128) % G2); S.ga1 = 128; S.gb1 = 32768; pg8::EpiLru E{A2, args.in[6], args.in[8], args.in[9], AH, BH};
          pg8::gemm_phase<pg8::EpiLru, pg8::GSched, true, PG8_SP2>(lds, 128, S, E); }
        }
    }
    SEAM(3);

    if (IN(4)) for (int rep_ = 0; rep_ <= ((PROBE_DUP_MASK >> 4) & 1); ++rep_) {
        PHASE_IDS();
        for (int it = (int)gt; it < 4 * 64 * 512; it += (int)NGT) {
            const int c2 = it & 511, k = (it >> 9) & 63, b = it >> 15;
            const size_t o0 = ((size_t)b * SEQ + k * 64) * 1024 + 2 * c2;
            const unsigned short* pa = AH + o0; const unsigned short* pb = BH + o0;
            float h0 = 0.f, h1 = 0.f, P0 = 1.f, P1 = 1.f;
#pragma unroll 8
            for (int t = 0; t < 64; ++t) { const unsigned dw = *(const unsigned*)(pa + (size_t)t * 1024), bw = *(const unsigned*)(pb + (size_t)t * 1024);
                const float a0 = 1.0f - h_lo(dw), a1 = 1.0f - h_hi(dw); h0 = a0 * h0 + h_lo(bw); h1 = a1 * h1 + h_hi(bw); P0 *= a0; P1 *= a1; }
            *(f32x2*)(SUMP + (size_t)(b * 64 + k) * 1024 + 2 * c2) = (f32x2){P0, P1}; *(f32x2*)(SUMH + (size_t)(b * 64 + k) * 1024 + 2 * c2) = (f32x2){h0, h1};
        }
    }
    SEAM(4);

    if (IN(5)) for (int rep_ = 0; rep_ <= ((PROBE_DUP_MASK >> 5) & 1); ++rep_) {
        PHASE_IDS();
        for (int it = (int)gt; it < 4 * 64 * 512; it += (int)NGT) {
            const int c2 = it & 511, k = (it >> 9) & 63, b = it >> 15;
            const float* sp = SUMP + (size_t)b * 65536 + 2 * c2; const float* sh = SUMH + (size_t)b * 65536 + 2 * c2;
            float h0 = 0.f, h1 = 0.f;
#pragma unroll 8
            for (int kk = 0; kk < k; ++kk) { const f32x2 p = *(const f32x2*)(sp + kk * 1024), q = *(const f32x2*)(sh + kk * 1024); h0 = h0 * p.x + q.x; h1 = h1 * p.y + q.y; }
            const size_t r0 = (size_t)b * SEQ + k * 64;
            const unsigned short* pa = AH + r0 * 1024 + 2 * c2; const unsigned short* pb = BH + r0 * 1024 + 2 * c2;
            const bf16_t* pg = PROJ + r0 * NPROJ + 2048 + 2 * c2; bf16_t* po = MIX + r0 * D + 1024 + 2 * c2;
#pragma unroll 8
            for (int t = 0; t < 64; ++t) { const unsigned dw = *(const unsigned*)(pa + (size_t)t * 1024), bw = *(const unsigned*)(pb + (size_t)t * 1024), gw2 = *(const unsigned*)(pg + (size_t)t * NPROJ);
                h0 = (1.0f - h_lo(dw)) * h0 + h_lo(bw); h1 = (1.0f - h_hi(dw)) * h1 + h_hi(bw);
                *(unsigned*)(po + (size_t)t * D) = cvt_pk_bf16(h0 * gelu_tanh(bf_lo(gw2)), h1 * gelu_tanh(bf_hi(gw2))); }
        }
    }
    SEAM(5);

    if (IN(6)) for (int rep_ = 0; rep_ <= ((PROBE_DUP_MASK >> 6) & 1); ++rep_) {
        pg8::GSched S; S.init(MIX, D, WOUT, D, 1, 64, 8, G, bid); pg8::EpiBf16 E{YB, D, 0, 0, 1, 0};
        pg8::gemm_phase<pg8::EpiBf16, pg8::GSched, true, PG8_SP2>(lds, D, S, E);
    }
    SEAM(6);
    if (IN(7)) for (int rep_ = 0; rep_ <= ((PROBE_DUP_MASK >> 7) & 1); ++rep_) { PHASE_IDS(); ln_rows<false>(x, YB, nullptr, args.in[14], args.in[15], XB, gw, NGW, lane); }
    SEAM(7);
    if (IN(8)) for (int rep_ = 0; rep_ <= ((PROBE_DUP_MASK >> 8) & 1); ++rep_) {
        pg8::GSched S; S.init(XB, D, WQ, D, 1, 64, 8, G, bid); pg8::EpiBf16 E{QB, D, 0, 0, 1, 0};
        pg8::gemm_phase<pg8::EpiBf16, pg8::GSched, true, PG8_SP2>(lds, D, S, E);
    }
    SEAM(8);
    if (IN(9)) for (int rep_ = 0; rep_ <= ((PROBE_DUP_MASK >> 9) & 1); ++rep_) {
        pg8::GSched S; S.init(QB, D, KB, D, 16, 16, 1, G, bid); S.gdiv = 4; S.ga1 = (long)SEQ * D; S.ga0 = 512; S.gb1 = 256L * D; S.gb0 = 512;
        pg8::EpiSoftmax E{PB, 0.04419417382415922f * 1.4426950408889634f};
        pg8::gemm_phase<pg8::EpiSoftmax, pg8::GSched, true, PG8_SP2>(lds, 512, S, E);
    }
    SEAM(9);
    if (IN(10)) for (int rep_ = 0; rep_ <= ((PROBE_DUP_MASK >> 10) & 1); ++rep_) {
        pg8::GSched S; S.init(PB, 256, VT, NMEMROWS, 16, 16, 2, G, bid); S.gdiv = 4; S.ga1 = 4L * SEQ * 256; S.ga0 = (long)SEQ * 256; S.gb1 = 256; S.gb0 = 512L * NMEMROWS;
        pg8::EpiBf16 E{OB, D, (long)SEQ * D, 512, 4, 0};
        pg8::gemm_phase<pg8::EpiBf16, pg8::GSched, true, PG8_SP2>(lds, 256, S, E);
    }
    SEAM(10);
    if (IN(11)) {
        pg8::GSched S; S.init(OB, D, WO, D, 1, 64, 8, G, bid); pg8::EpiResStat E{XB, STATS2};
        pg8::gemm_phase<pg8::EpiResStat, pg8::GSched, true, PG8_SP2>(lds, D, S, E);
    }
    SEAM(11);
    constexpr size_t CH_ROWS = T / 2;
    if (IN(13)) {
        { pg8::GSched S; S.init(XB, D, WFF1, D, 1, 32, 32, G, bid); pg8::EpiFF1 E{HB, STATS2, C1, C2, 0};
          pg8::gemm_phase<pg8::EpiFF1, pg8::GSched, true, PG8_SP2>(lds, D, S, E); }
        xcd_barrier(bar);
        { pg8::GSched S; S.init(HB, DFF, WFF2, DFF, 1, 32, 8, G, bid); pg8::EpiBf16 E{Y3, D, 0, 0, 1, 0};
          pg8::gemm_phase<pg8::EpiBf16, pg8::GSched, true, PG8_SP2>(lds, DFF, S, E); }
        { pg8::GSched S; S.init(XB + CH_ROWS * D, D, WFF1, D, 1, 32, 32, G, bid); pg8::EpiFF1 E{HB + CH_ROWS * DFF, STATS2, C1, C2, (int)CH_ROWS};
          pg8::gemm_phase<pg8::EpiFF1, pg8::GSched, true, PG8_SP2>(lds, D, S, E); }
    }
    SEAM(13);
    if (IN(14)) {
        pg8::GSched S; S.init(HB + CH_ROWS * DFF, DFF, WFF2, DFF, 1, 32, 8, G, bid); pg8::EpiBf16 E{Y3 + CH_ROWS * D, D, 0, 0, 1, 0};
        pg8::gemm_phase<pg8::EpiBf16, pg8::GSched, true, PG8_SP2>(lds, DFF, S, E);
    }
    SEAM(14);
    if (IN(15)) for (int rep_ = 0; rep_ <= ((PROBE_DUP_MASK >> 15) & 1); ++rep_) { PHASE_IDS(); ln_rows_folded(XB, STATS2, args.in[20], args.in[21], Y3, out, args.in[24], args.in[25], gw, NGW, lane); }
#undef IN
#undef SEAM
}

extern "C" void kernel_launch(void* const* d_in, const int* in_sizes, int n_in, void* d_out, int out_size, void* d_ws, size_t ws_size, hipStream_t stream) {
    static int grid = 0;
    if (grid == 0) {
        if (n_in != 26 || out_size != T * D || ws_size < WS_END) { fprintf(stderr, "kernel_launch: unexpected shapes (n_in %d out %d ws %zu)\n", n_in, out_size, ws_size); grid = -1; return; }
        int dev = 0, cus = 0, per_cu = 0;
        (void)hipGetDevice(&dev);
        (void)hipDeviceGetAttribute(&cus, hipDeviceAttributeMultiprocessorCount, dev);
        if (hipFuncSetAttribute((const void*)fwd_mega, hipFuncAttributeMaxDynamicSharedMemorySize, LDS_BYTES) != hipSuccess) { fprintf(stderr, "kernel_launch: hipFuncSetAttribute failed\n"); grid = -1; return; }
        if (hipOccupancyMaxActiveBlocksPerMultiprocessor(&per_cu, (const void*)fwd_mega, 512, LDS_BYTES) != hipSuccess || per_cu < 1) { fprintf(stderr, "kernel_launch: occupancy query says %d\n", per_cu); grid = -1; return; }
        grid = cus;
        if (grid % 8 != 0 || grid > 1024) { fprintf(stderr, "kernel_launch: unexpected CU count %d\n", cus); }
    }
    if (grid < 0) return;
    if (hipMemsetAsync((char*)d_ws + WS_CTL, 0, CTL_ZERO, stream) != hipSuccess) { fprintf(stderr, "kernel_launch: memset failed\n"); return; }
    Args a{};
    for (int i = 0; i < 26; ++i) a.in[i] = (const float*)d_in[i];
    a.out = (float*)d_out; a.ws = (unsigned char*)d_ws;
#if MK_N_LAUNCHES == 1
#if PROBE_PREFIX >= 0
    { a.ph_lo = 0; a.ph_hi = PROBE_PREFIX + 1; void* kargs0[] = {&a};
      (void)hipLaunchCooperativeKernel((const void*)fwd_mega, dim3(grid), dim3(512), kargs0, LDS_BYTES, stream);
      (void)hipMemsetAsync((char*)d_ws + WS_CTL, 0, CTL_ZERO, stream); }
#endif
    a.ph_lo = 0; a.ph_hi = N_PHASES + 1;
    void* kargs[] = {&a};
    hipError_t e = hipLaunchCooperativeKernel((const void*)fwd_mega, dim3(grid), dim3(512), kargs, LDS_BYTES, stream);
    if (e != hipSuccess) fprintf(stderr, "kernel_launch: cooperative launch failed: %s (grid %d)\n", hipGetErrorString(e), grid);
#else
    for (int p = 0; p <= N_PHASES; ++p) { a.ph_lo = p; a.ph_hi = p + 1; hipLaunchKernelGGL(fwd_mega, dim3(grid), dim3(512), LDS_BYTES, stream, a); }
#endif
}
```

```cpp
#include <hip/hip_runtime.h>
#include <hip/hip_cooperative_groups.h>
#include <cstdio>
#include <cstdint>
namespace cg = cooperative_groups;

#ifndef PROBE_DUP_MASK
#define PROBE_DUP_MASK 0
#endif
#ifndef PROBE_LN
#define PROBE_LN 0
#endif
#ifndef PROBE_PREFIX
#define PROBE_PREFIX -1
#endif
#ifndef MK_N_LAUNCHES
#define MK_N_LAUNCHES 1
#endif

#define LAS __attribute__((address_space(3)))
typedef unsigned short bf16_t;
typedef short bf16x8 __attribute__((ext_vector_type(8)));
typedef float f32x4 __attribute__((ext_vector_type(4)));
typedef float f32x2 __attribute__((ext_vector_type(2)));
typedef unsigned u32x4 __attribute__((ext_vector_type(4)));
typedef unsigned u32x2 __attribute__((ext_vector_type(2)));
typedef _Float16 f16x2 __attribute__((ext_vector_type(2)));

constexpr int T = 16384, SEQ = 4096, D = 2048, NPROJ = 3072, DFF = 8192, NMEMROWS = 1024;
constexpr float LN_EPS = 1e-5f;
constexpr float ALPHA = 1.189207115002721f;

constexpr size_t MiB = 1u << 20;
constexpr size_t WS_CTL = 0, CTL_BYTES = 1 * MiB;
constexpr size_t CTL_C1 = 64 * 1024, CTL_C2 = 96 * 1024, CTL_STATS2 = 128 * 1024, CTL_ZERO = 256 * 1024;
constexpr size_t WS_WFF1 = 2 * MiB, WS_WFF2 = 34 * MiB, WS_WIN = 66 * MiB, WS_WOUT = 78 * MiB, WS_WQ = 86 * MiB, WS_WK = 94 * MiB, WS_WV = 102 * MiB, WS_WO = 110 * MiB;
constexpr size_t WS_Y3 = 66 * MiB;
constexpr size_t WS_WPOOL = 118 * MiB, WS_WAX = 118 * MiB + 512 * 1024;
constexpr size_t WS_MEMB = 119 * MiB, WS_KB = 123 * MiB, WS_VT = 127 * MiB;
constexpr size_t WS_XB = 131 * MiB;
constexpr size_t WS_BF = 131 * MiB;
constexpr size_t WS_PROJ = 195 * MiB;
constexpr size_t WS_Q = 195 * MiB;
constexpr size_t WS_PB = 259 * MiB;
constexpr size_t WS_A2 = 291 * MiB;
constexpr size_t WS_SUM = 291 * MiB;
constexpr size_t WS_O = 291 * MiB;
constexpr size_t WS_MIX = 355 * MiB;
constexpr size_t WS_AF = 419 * MiB;
constexpr size_t WS_H = 195 * MiB;
constexpr size_t WS_END = 483 * MiB;

constexpr int LDS_BYTES = 147456;
constexpr int LDS_X = 131072;
constexpr int LDS_BARST = 131072 + 8192;

__device__ __forceinline__ unsigned cvt_pk_bf16(float lo, float hi) { unsigned r; asm volatile("v_cvt_pk_bf16_f32 %0, %1, %2" : "=v"(r) : "v"(lo), "v"(hi)); return r; }
__device__ __forceinline__ float bf_lo(unsigned w) { return __uint_as_float(w << 16); }
__device__ __forceinline__ float bf_hi(unsigned w) { return __uint_as_float(w & 0xffff0000u); }
__device__ __forceinline__ float bf2f(bf16_t b) { return __uint_as_float(((unsigned)b) << 16); }
__device__ __forceinline__ bf16_t f2bf(float f) { unsigned u = __float_as_uint(f); return (bf16_t)((u + 0x7fffu + ((u >> 16) & 1u)) >> 16); }
__device__ __forceinline__ float wave_sum(float v) {
#pragma unroll
    for (int o = 1; o < 64; o <<= 1) v += __shfl_xor(v, o);
    return v;
}
__device__ __forceinline__ unsigned pk_f16(float lo, float hi) { f16x2 v; v.x = (_Float16)lo; v.y = (_Float16)hi; return __builtin_bit_cast(unsigned, v); }
__device__ __forceinline__ float h_lo(unsigned w) { return (float)__builtin_bit_cast(f16x2, w).x; }
__device__ __forceinline__ float h_hi(unsigned w) { return (float)__builtin_bit_cast(f16x2, w).y; }
__device__ __forceinline__ float sigmoidf_(float x) { return 1.0f / (1.0f + __expf(-x)); }
__device__ __forceinline__ float gelu_tanh(float x) {
    const float z = 0.7978845608028654f * (x + 0.044715f * x * x * x);
    const float e = __expf(2.0f * z);
    const float th = 1.0f - 2.0f / (e + 1.0f);
    return 0.5f * x * (1.0f + th);
}

namespace pg8 {
constexpr int BM = 256, BK = 64, HALF = 128, HTB = HALF * BK * 2, STAGE_BYTES = 8 * HTB, NXCD = 8, WGM = 8;
__host__ __device__ __forceinline__ int lds_byte(int r, int c) { const int st = (r >> 4) * 2 + (c >> 5), rr = r & 15, cc = c & 31, ob = rr * 64 + cc * 2; return st * 1024 + (ob ^ (((ob >> 9) & 1) << 5)); }
__host__ __device__ __forceinline__ void stage_rc(int b, int& R, int& C) { const int st = b / 1024, sb = b % 1024, swz = sb ^ (((sb >> 9) & 1) << 5); R = (st >> 1) * 16 + swz / 64; C = (st & 1) * 32 + (swz % 64) / 2; }
__host__ __device__ __forceinline__ int perm32(int rho) { const int n = rho >> 4, i = rho & 15; return 8 * (i >> 2) + 4 * n + (i & 3); }

struct Unit { int pm, pn, g; };

struct GSched {
    const bf16_t* A; const bf16_t* Bt;
    long ga1, ga0, gb1, gb0; int gdiv;
    int lda, ldb, nMg, nVM, nN, nwg, G, c, wgm;
    __device__ __forceinline__ void init(const bf16_t* A_, int lda_, const bf16_t* Bt_, int ldb_, int nG, int nMg_, int nN_, int G_, int c_) {
        A = A_; Bt = Bt_; lda = lda_; ldb = ldb_; nMg = nMg_; nVM = nG * nMg_; nN = nN_; nwg = nVM * nN_; G = G_; c = c_;
        ga1 = ga0 = gb1 = gb0 = 0; gdiv = 1; wgm = WGM;
    }
    __device__ __forceinline__ bool next(int i, Unit& u) const {
        const long L = (long)i * G + c; if (L >= nwg) return false;
        int wgid = (int)L; { const int q = nwg / NXCD, r = nwg % NXCD, xcd = wgid % NXCD, off = wgid / NXCD; wgid = (xcd < r ? xcd * (q + 1) : r * (q + 1) + (xcd - r) * q) + off; }
        const int nig = wgm * nN, gid = wgid / nig, fm = gid * wgm, gsz = (nVM - fm) < wgm ? (nVM - fm) : wgm;
        const int vm = fm + ((wgid % nig) % gsz); u.pn = (wgid % nig) / gsz; u.g = vm / nMg; u.pm = vm % nMg; return true;
    }
    __device__ __forceinline__ const char* a_ptr(const Unit& u) const { return (const char*)(A + (long)(u.g / gdiv) * ga1 + (long)(u.g % gdiv) * ga0 + (long)u.pm * BM * lda); }
    __device__ __forceinline__ const char* b_ptr(const Unit& u) const { return (const char*)(Bt + (long)(u.g / gdiv) * gb1 + (long)(u.g % gdiv) * gb0 + (long)u.pn * BM * ldb); }
};

struct EpiBf16 {
    static constexpr bool PERM = true;
    bf16_t* O; int ldc; long go1, go0; int gdiv; int act;
    __device__ __forceinline__ void operator()(f32x4 (&acc)[2][2][4][2], const Unit& u, int wr, int wc, int fr, int fq, LAS unsigned char*) const {
        bf16_t* base = O + (long)(u.g / gdiv) * go1 + (long)(u.g % gdiv) * go0 + ((size_t)u.pm * BM + wr * 64 + fr) * ldc + u.pn * BM + wc * 32 + 8 * fq;
#pragma unroll
        for (int ai = 0; ai < 2; ++ai)
#pragma unroll
            for (int m = 0; m < 4; ++m) { bf16_t* rowp = base + (size_t)(ai * HALF + m * 16) * ldc;
#pragma unroll
                for (int bj = 0; bj < 2; ++bj) { f32x4 v0 = acc[ai][bj][m][0], v1 = acc[ai][bj][m][1];
                    if (act == 1) {
#pragma unroll
                        for (int j = 0; j < 4; ++j) { const float a0 = fmaxf(v0[j], 0.f), a1 = fmaxf(v1[j], 0.f); v0[j] = a0 * a0; v1[j] = a1 * a1; } }
                    u32x4 w; w.x = cvt_pk_bf16(v0[0], v0[1]); w.y = cvt_pk_bf16(v0[2], v0[3]); w.z = cvt_pk_bf16(v1[0], v1[1]); w.w = cvt_pk_bf16(v1[2], v1[3]);
                    *(u32x4*)(rowp + bj * HALF) = w; } }
    }
};
struct EpiResStat {
    static constexpr bool PERM = true;
    bf16_t* X; float* stats;
    __device__ __forceinline__ void operator()(f32x4 (&acc)[2][2][4][2], const Unit& u, int wr, int wc, int fr, int fq, LAS unsigned char*) const {
        bf16_t* base = X + ((size_t)u.pm * BM + wr * 64 + fr) * D + u.pn * BM + wc * 32 + 8 * fq;
        u32x4 xr[2][4][2];
#pragma unroll
        for (int ai = 0; ai < 2; ++ai)
#pragma unroll
            for (int m = 0; m < 4; ++m)
#pragma unroll
                for (int bj = 0; bj < 2; ++bj) xr[ai][m][bj] = *(const u32x4*)(base + (size_t)(ai * HALF + m * 16) * D + bj * HALF);
#pragma unroll
        for (int ai = 0; ai < 2; ++ai)
#pragma unroll
            for (int m = 0; m < 4; ++m) { float s = 0.f, q = 0.f;
#pragma unroll
                for (int bj = 0; bj < 2; ++bj) { const u32x4 x = xr[ai][m][bj]; const f32x4 a0 = acc[ai][bj][m][0], a1 = acc[ai][bj][m][1];
                    u32x4 w; w.x = cvt_pk_bf16(bf_lo(x.x) * ALPHA + a0[0], bf_hi(x.x) * ALPHA + a0[1]); w.y = cvt_pk_bf16(bf_lo(x.y) * ALPHA + a0[2], bf_hi(x.y) * ALPHA + a0[3]);
                    w.z = cvt_pk_bf16(bf_lo(x.z) * ALPHA + a1[0], bf_hi(x.z) * ALPHA + a1[1]); w.w = cvt_pk_bf16(bf_lo(x.w) * ALPHA + a1[2], bf_hi(x.w) * ALPHA + a1[3]);
                    const float z[8] = {bf_lo(w.x), bf_hi(w.x), bf_lo(w.y), bf_hi(w.y), bf_lo(w.z), bf_hi(w.z), bf_lo(w.w), bf_hi(w.w)};
#pragma unroll
                    for (int e = 0; e < 8; ++e) { s += z[e]; q += z[e] * z[e]; }
                    *(u32x4*)(base + (size_t)(ai * HALF + m * 16) * D + bj * HALF) = w; }
                s += __shfl_xor(s, 16); s += __shfl_xor(s, 32); q += __shfl_xor(q, 16); q += __shfl_xor(q, 32);
                if (fq == 0) { float* st = stats + 2 * ((size_t)u.pm * BM + ai * HALF + wr * 64 + m * 16 + fr);
                    __hip_atomic_fetch_add(st, s, __ATOMIC_RELAXED, __HIP_MEMORY_SCOPE_AGENT); __hip_atomic_fetch_add(st + 1, q, __ATOMIC_RELAXED, __HIP_MEMORY_SCOPE_AGENT); } }
    }
};
struct EpiFF1 {
    static constexpr bool PERM = true;
    bf16_t* O; const float* stats; const float* c1; const float* c2; int row0;
    __device__ __forceinline__ void operator()(f32x4 (&acc)[2][2][4][2], const Unit& u, int wr, int wc, int fr, int fq, LAS unsigned char*) const {
        const int col0 = u.pn * BM + wc * 32 + 8 * fq;
        bf16_t* base = O + ((size_t)u.pm * BM + wr * 64 + fr) * DFF + col0;
        f32x4 c1v[2][2], c2v[2][2];
#pragma unroll
        for (int bj = 0; bj < 2; ++bj)
#pragma unroll
            for (int n = 0; n < 2; ++n) { c1v[bj][n] = *(const f32x4*)(c1 + col0 + bj * HALF + 4 * n); c2v[bj][n] = *(const f32x4*)(c2 + col0 + bj * HALF + 4 * n); }
        f32x2 st[2][4];
#pragma unroll
        for (int ai = 0; ai < 2; ++ai)
#pragma unroll
            for (int m = 0; m < 4; ++m) st[ai][m] = *(const f32x2*)(stats + 2 * ((size_t)row0 + (size_t)u.pm * BM + ai * HALF + wr * 64 + m * 16 + fr));
#pragma unroll
        for (int ai = 0; ai < 2; ++ai)
#pragma unroll
            for (int m = 0; m < 4; ++m) { bf16_t* rowp = base + (size_t)(ai * HALF + m * 16) * DFF;
                const float mean = st[ai][m].x * (1.0f / D); const float var = fmaxf(st[ai][m].y * (1.0f / D) - mean * mean, 0.f); const float rstd = 1.0f / sqrtf(var + LN_EPS);
#pragma unroll
                for (int bj = 0; bj < 2; ++bj) { f32x4 v0 = (acc[ai][bj][m][0] - c1v[bj][0] * mean) * rstd + c2v[bj][0], v1 = (acc[ai][bj][m][1] - c1v[bj][1] * mean) * rstd + c2v[bj][1];
#pragma unroll
                    for (int j = 0; j < 4; ++j) { const float a0 = fmaxf(v0[j], 0.f), a1 = fmaxf(v1[j], 0.f); v0[j] = a0 * a0; v1[j] = a1 * a1; }
                    u32x4 w; w.x = cvt_pk_bf16(v0[0], v0[1]); w.y = cvt_pk_bf16(v0[2], v0[3]); w.z = cvt_pk_bf16(v1[0], v1[1]); w.w = cvt_pk_bf16(v1[2], v1[3]);
                    *(u32x4*)(rowp + bj * HALF) = w; } }
    }
};
struct EpiPool {
    static constexpr bool PERM = true;
    bf16_t* O; const float* bias; const float* scale;
    __device__ __forceinline__ void operator()(f32x4 (&acc)[2][2][4][2], const Unit& u, int wr, int wc, int fr, int fq, LAS unsigned char*) const {
        const int col0 = u.g * 256 + wc * 32 + 8 * fq;
        bf16_t* base = O + ((size_t)u.pm * BM + wr * 64 + fr) * D + col0;
        f32x4 bv[2][2], sv[2][2];
#pragma unroll
        for (int bj = 0; bj < 2; ++bj)
#pragma unroll
            for (int n = 0; n < 2; ++n) { bv[bj][n] = *(const f32x4*)(bias + col0 + bj * HALF + 4 * n); sv[bj][n] = *(const f32x4*)(scale + col0 + bj * HALF + 4 * n); }
#pragma unroll
        for (int ai = 0; ai < 2; ++ai)
#pragma unroll
            for (int m = 0; m < 4; ++m) { bf16_t* rowp = base + (size_t)(ai * HALF + m * 16) * D;
#pragma unroll
                for (int bj = 0; bj < 2; ++bj) { const f32x4 v0 = (acc[ai][bj][m][0] + bv[bj][0]) * sv[bj][0], v1 = (acc[ai][bj][m][1] + bv[bj][1]) * sv[bj][1];
                    u32x4 w; w.x = cvt_pk_bf16(v0[0], v0[1]); w.y = cvt_pk_bf16(v0[2], v0[3]); w.z = cvt_pk_bf16(v1[0], v1[1]); w.w = cvt_pk_bf16(v1[2], v1[3]);
                    *(u32x4*)(rowp + bj * HALF) = w; } }
    }
};
struct EpiLru {
    static constexpr bool PERM = true;
    const bf16_t* A2; const float* b_a; const float* b_x; const float* lam; unsigned short* AH; unsigned short* BH;
    __device__ __forceinline__ void operator()(f32x4 (&acc)[2][2][4][2], const Unit& u, int wr, int wc, int fr, int fq, LAS unsigned char*) const {
        const int ch0 = u.g * 128 + wc * 32 + 8 * fq;
        f32x4 ba[2], bx[2], nsp[2];
#pragma unroll
        for (int n = 0; n < 2; ++n) { ba[n] = *(const f32x4*)(b_a + ch0 + 4 * n); bx[n] = *(const f32x4*)(b_x + ch0 + 4 * n); const f32x4 l = *(const f32x4*)(lam + ch0 + 4 * n);
#pragma unroll
            for (int j = 0; j < 4; ++j) nsp[n][j] = -8.0f * log1pf(__expf(-l[j])); }
        u32x4 xw[2][4];
#pragma unroll
        for (int ai = 0; ai < 2; ++ai)
#pragma unroll
            for (int m = 0; m < 4; ++m) { const int row = u.pm * BM + ai * HALF + wr * 64 + m * 16 + fr; xw[ai][m] = *(const u32x4*)(A2 + (size_t)row * D + 1024 + ch0); }
#pragma unroll
        for (int ai = 0; ai < 2; ++ai)
#pragma unroll
            for (int m = 0; m < 4; ++m) { const int row = u.pm * BM + ai * HALF + wr * 64 + m * 16 + fr; const bool first = (row & (SEQ - 1)) == 0;
                const float xc[2][4] = {{bf_lo(xw[ai][m].x), bf_hi(xw[ai][m].x), bf_lo(xw[ai][m].y), bf_hi(xw[ai][m].y)}, {bf_lo(xw[ai][m].z), bf_hi(xw[ai][m].z), bf_lo(xw[ai][m].w), bf_hi(xw[ai][m].w)}};
                float dv[2][4], bv[2][4];
#pragma unroll
                for (int n = 0; n < 2; ++n)
#pragma unroll
                    for (int j = 0; j < 4; ++j) {
                        const float r = sigmoidf_(acc[ai][0][m][n][j] + ba[n][j]);
                        const float ig = sigmoidf_(acc[ai][1][m][n][j] + bx[n][j]);
                        const float la = nsp[n][j] * r;
                        const float a = __expf(la);
                        const float mult = first ? 1.0f : sqrtf(fmaxf(1.0f - a * a, 0.f));
                        dv[n][j] = 1.0f - a; bv[n][j] = mult * ig * xc[n][j]; }
                u32x4 dw, bw;
                dw.x = pk_f16(dv[0][0], dv[0][1]); dw.y = pk_f16(dv[0][2], dv[0][3]); dw.z = pk_f16(dv[1][0], dv[1][1]); dw.w = pk_f16(dv[1][2], dv[1][3]);
                bw.x = pk_f16(bv[0][0], bv[0][1]); bw.y = pk_f16(bv[0][2], bv[0][3]); bw.z = pk_f16(bv[1][0], bv[1][1]); bw.w = pk_f16(bv[1][2], bv[1][3]);
                *(u32x4*)(AH + (size_t)row * 1024 + ch0) = dw; *(u32x4*)(BH + (size_t)row * 1024 + ch0) = bw; }
    }
};
struct EpiSoftmax {
    static constexpr bool PERM = true;
    bf16_t* P; float scale_log2e;
    __device__ __forceinline__ void operator()(f32x4 (&acc)[2][2][4][2], const Unit& u, int wr, int wc, int fr, int fq, LAS unsigned char* lds) const {
        LAS f32x2* X = (LAS f32x2*)(lds + LDS_X);
        float mxs[2][4];
#pragma unroll
        for (int ai = 0; ai < 2; ++ai)
#pragma unroll
            for (int m = 0; m < 4; ++m) {
                float mx = -3.0e38f;
#pragma unroll
                for (int bj = 0; bj < 2; ++bj)
#pragma unroll
                    for (int n = 0; n < 2; ++n) { acc[ai][bj][m][n] = acc[ai][bj][m][n] * scale_log2e; const f32x4 x = acc[ai][bj][m][n]; mx = fmaxf(mx, fmaxf(fmaxf(x[0], x[1]), fmaxf(x[2], x[3]))); }
                mx = fmaxf(mx, __shfl_xor(mx, 16)); mx = fmaxf(mx, __shfl_xor(mx, 32));
                float s = 0.f;
#pragma unroll
                for (int bj = 0; bj < 2; ++bj)
#pragma unroll
                    for (int n = 0; n < 2; ++n) { f32x4 x = acc[ai][bj][m][n];
#pragma unroll
                        for (int j = 0; j < 4; ++j) { x[j] = __builtin_amdgcn_exp2f(x[j] - mx); s += x[j]; }
                        acc[ai][bj][m][n] = x; }
                s += __shfl_xor(s, 16); s += __shfl_xor(s, 32);
                mxs[ai][m] = mx;
                if (fq == 0) X[(ai * HALF + wr * 64 + m * 16 + fr) * 4 + wc] = (f32x2){mx, s};
            }
        asm volatile("s_waitcnt lgkmcnt(0)" ::: "memory"); __builtin_amdgcn_s_barrier(); asm volatile("" ::: "memory");
        bf16_t* base = P + ((size_t)u.g * SEQ + (size_t)u.pm * BM + wr * 64 + fr) * 256 + wc * 32 + 8 * fq;
#pragma unroll
        for (int ai = 0; ai < 2; ++ai)
#pragma unroll
            for (int m = 0; m < 4; ++m) { const int r = ai * HALF + wr * 64 + m * 16 + fr;
                const f32x2 p0 = X[r * 4 + 0], p1 = X[r * 4 + 1], p2 = X[r * 4 + 2], p3 = X[r * 4 + 3];
                const float M = fmaxf(fmaxf(p0.x, p1.x), fmaxf(p2.x, p3.x));
                const float tot = p0.y * __builtin_amdgcn_exp2f(p0.x - M) + p1.y * __builtin_amdgcn_exp2f(p1.x - M) + p2.y * __builtin_amdgcn_exp2f(p2.x - M) + p3.y * __builtin_amdgcn_exp2f(p3.x - M);
                const float f = __builtin_amdgcn_exp2f(mxs[ai][m] - M) / tot;
                bf16_t* rowp = base + (size_t)(ai * HALF + m * 16) * 256;
#pragma unroll
                for (int bj = 0; bj < 2; ++bj) { const f32x4 v0 = acc[ai][bj][m][0] * f, v1 = acc[ai][bj][m][1] * f;
                    u32x4 w; w.x = cvt_pk_bf16(v0[0], v0[1]); w.y = cvt_pk_bf16(v0[2], v0[3]); w.z = cvt_pk_bf16(v1[0], v1[1]); w.w = cvt_pk_bf16(v1[2], v1[3]);
                    *(u32x4*)(rowp + bj * HALF) = w; } }
    }
};

template <class Epi, class Sched, bool ALIGN_EPI, bool SP2>
__device__ __forceinline__ void gemm_phase(LAS unsigned char* lds, const int K_, const Sched& S, const Epi& E) {
    int K = K_; asm volatile("" : "+s"(K));
    int tid_ = threadIdx.x; asm volatile("" : "+v"(tid_));
    const int tid = tid_, wid = __builtin_amdgcn_readfirstlane(tid >> 6), lane = tid & 63, wr = wid >> 2, wc = wid & 3, fr = lane & 15, fq = lane >> 4;
    const int nt = K / BK;
    unsigned voffA[2], voffB[2];
#pragma unroll
    for (int i = 0; i < 2; ++i) { int R, C; stage_rc(tid * 16 + i * 8192, R, C); const int Rb = Epi::PERM ? ((R & ~31) + perm32(R & 31)) : R;
        voffA[i] = (unsigned)(R * S.lda + C) * 2u; voffB[i] = (unsigned)(Rb * S.ldb + C) * 2u; }
    const size_t kstep = (size_t)(BK * 2);
    const size_t hstepA = (size_t)HALF * S.lda * 2, hstepB = (size_t)HALF * S.ldb * 2;
    const unsigned ldsw = (unsigned)wid * 1024u;
    const int aoff = lds_byte(wr * 64 + fr, fq * 8), boff = lds_byte(wc * 32 + fr, fq * 8);
#define PG8_SA(b, h) (((b) * 2 + (h)) * HTB)
#define PG8_SB(b, h) ((4 + (b) * 2 + (h)) * HTB)
#define PG8_STAGE(bufoff, gbase, voff) do { _Pragma("unroll") for (int _i = 0; _i < 2; ++_i) \
        __builtin_amdgcn_global_load_lds((const unsigned*)((const char*)(gbase) + (voff)[_i]), (LAS unsigned*)(lds + (bufoff) + ldsw + _i * 8192), 16, 0, 0); } while (0)
#define PG8_LDA(dst, b, h) do { _Pragma("unroll") for (int m = 0; m < 4; ++m) _Pragma("unroll") for (int k = 0; k < 2; ++k) dst[m][k] = *(const LAS bf16x8*)(lds + PG8_SA(b, h) + aoff + m * 2048 + k * 1024); } while (0)
#define PG8_LDB(dst, b, h) do { _Pragma("unroll") for (int n = 0; n < 2; ++n) _Pragma("unroll") for (int k = 0; k < 2; ++k) dst[n][k] = *(const LAS bf16x8*)(lds + PG8_SB(b, h) + boff + n * 2048 + k * 1024); } while (0)
#define PG8_MMA(ai, bj, At, Bt) do { __builtin_amdgcn_s_setprio(1); _Pragma("unroll") for (int m = 0; m < 4; ++m) _Pragma("unroll") for (int n = 0; n < 2; ++n) _Pragma("unroll") for (int k = 0; k < 2; ++k) \
        acc[ai][bj][m][n] = __builtin_amdgcn_mfma_f32_16x16x32_bf16(Bt[n][k], At[m][k], acc[ai][bj][m][n], 0, 0, 0); __builtin_amdgcn_s_setprio(0); } while (0)
#define PG8_WAIT_V(n) asm volatile("s_waitcnt vmcnt(" #n ")" ::: "memory")
#define PG8_WAIT_L(n) asm volatile("s_waitcnt lgkmcnt(" #n ")" ::: "memory")
#define PG8_BAR __builtin_amdgcn_s_barrier()
#define PG8_SCHED __builtin_amdgcn_sched_barrier(0)
    Unit cur, nxt; int ui = 0;
    if (!S.next(0, cur)) return;
    f32x4 acc[2][2][4][2];
#pragma unroll
    for (int a = 0; a < 2; ++a)
#pragma unroll
        for (int b = 0; b < 2; ++b)
#pragma unroll
            for (int m = 0; m < 4; ++m)
#pragma unroll
                for (int n = 0; n < 2; ++n) acc[a][b][m][n] = (f32x4){0.f, 0.f, 0.f, 0.f};
    bf16x8 At[4][2], B0[2][2], B1[2][2];
    const char* cA = S.a_ptr(cur); const char* cB = S.b_ptr(cur);
    if constexpr (SP2) {
        PG8_STAGE(PG8_SB(0, 0), cB, voffB); PG8_STAGE(PG8_SB(0, 1), cB + hstepB, voffB); PG8_STAGE(PG8_SA(0, 0), cA, voffA); PG8_STAGE(PG8_SA(0, 1), cA + hstepA, voffA);
        if (wr == 1) PG8_BAR;
        PG8_WAIT_V(2); PG8_BAR;
        PG8_STAGE(PG8_SB(1, 0), cB + kstep, voffB); PG8_STAGE(PG8_SA(1, 0), cA + kstep, voffA); PG8_STAGE(PG8_SB(1, 1), cB + hstepB + kstep, voffB);
        PG8_WAIT_V(6); PG8_BAR;
    } else {
        PG8_STAGE(PG8_SB(0, 0), cB, voffB); PG8_STAGE(PG8_SA(0, 0), cA, voffA); PG8_STAGE(PG8_SB(0, 1), cB + hstepB, voffB); PG8_STAGE(PG8_SA(0, 1), cA + hstepA, voffA);
        if (wr == 1) PG8_BAR;
        PG8_WAIT_V(4); PG8_BAR;
        PG8_STAGE(PG8_SB(1, 0), cB + kstep, voffB); PG8_STAGE(PG8_SA(1, 0), cA + kstep, voffA); PG8_STAGE(PG8_SB(1, 1), cB + hstepB + kstep, voffB);
        PG8_WAIT_V(6); PG8_BAR;
    }
    for (;;) {
        const bool has_next = S.next(ui + 1, nxt);
        const char* nA = has_next ? S.a_ptr(nxt) : cA; const char* nB = has_next ? S.b_ptr(nxt) : cB;
        for (int t = 0; t < nt; t += 2) {
            const bool last = (t == nt - 2);
            const char* a1 = cA + (size_t)(t + 1) * kstep;
            const char* a2 = last ? nA : cA + (size_t)(t + 2) * kstep; const char* b2 = last ? nB : cB + (size_t)(t + 2) * kstep;
            const char* a3 = a2 + kstep; const char* b3 = b2 + kstep;
            if constexpr (SP2) {
            PG8_LDB(B0, 0, 0); PG8_LDB(B1, 0, 1); PG8_SCHED; PG8_LDA(At, 0, 0); PG8_STAGE(PG8_SA(1, 1), a1 + hstepA, voffA);
            PG8_WAIT_V(8); PG8_WAIT_L(0); PG8_BAR; PG8_MMA(0, 0, At, B0); PG8_MMA(0, 1, At, B1); PG8_BAR; PG8_SCHED;
            PG8_LDA(At, 0, 1); PG8_STAGE(PG8_SB(0, 0), b2, voffB); PG8_STAGE(PG8_SB(0, 1), b2 + hstepB, voffB); PG8_STAGE(PG8_SA(0, 0), a2, voffA);
            PG8_WAIT_V(8); PG8_WAIT_L(0); PG8_BAR; PG8_MMA(1, 0, At, B0); PG8_MMA(1, 1, At, B1); PG8_BAR; PG8_SCHED;
            PG8_LDB(B0, 1, 0); PG8_LDB(B1, 1, 1); PG8_SCHED; PG8_LDA(At, 1, 0); PG8_STAGE(PG8_SA(0, 1), a2 + hstepA, voffA);
            PG8_WAIT_V(8); PG8_WAIT_L(0); PG8_BAR; PG8_MMA(0, 0, At, B0); PG8_MMA(0, 1, At, B1); PG8_BAR; PG8_SCHED;
            PG8_LDA(At, 1, 1); PG8_STAGE(PG8_SB(1, 0), b3, voffB); PG8_STAGE(PG8_SB(1, 1), b3 + hstepB, voffB); PG8_STAGE(PG8_SA(1, 0), a3, voffA);
            PG8_WAIT_V(8); PG8_WAIT_L(0); PG8_BAR; PG8_MMA(1, 0, At, B0); PG8_MMA(1, 1, At, B1); PG8_BAR; PG8_SCHED;
            } else {
            PG8_LDB(B0, 0, 0); PG8_SCHED; PG8_LDA(At, 0, 0); PG8_STAGE(PG8_SA(1, 1), a1 + hstepA, voffA);
            PG8_WAIT_L(8); PG8_BAR; PG8_WAIT_L(0); PG8_MMA(0, 0, At, B0); PG8_BAR; PG8_SCHED;
            PG8_LDB(B1, 0, 1); PG8_STAGE(PG8_SB(0, 0), b2, voffB);
            PG8_BAR; PG8_WAIT_L(0); PG8_MMA(0, 1, At, B1); PG8_BAR;
            PG8_LDA(At, 0, 1); PG8_STAGE(PG8_SA(0, 0), a2, voffA);
            PG8_BAR; PG8_WAIT_L(0); PG8_MMA(1, 0, At, B0); PG8_BAR; PG8_SCHED;
            PG8_STAGE(PG8_SB(0, 1), b2 + hstepB, voffB);
            PG8_WAIT_V(6); PG8_BAR; PG8_MMA(1, 1, At, B1); PG8_BAR;
            PG8_LDB(B0, 1, 0); PG8_SCHED; PG8_LDA(At, 1, 0); PG8_STAGE(PG8_SA(0, 1), a2 + hstepA, voffA);
            PG8_WAIT_L(8); PG8_BAR; PG8_WAIT_L(0); PG8_MMA(0, 0, At, B0); PG8_BAR; PG8_SCHED;
            PG8_LDB(B1, 1, 1); PG8_STAGE(PG8_SB(1, 0), b3, voffB);
            PG8_BAR; PG8_WAIT_L(0); PG8_MMA(0, 1, At, B1); PG8_BAR;
            PG8_LDA(At, 1, 1); PG8_STAGE(PG8_SA(1, 0), a3, voffA);
            PG8_BAR; PG8_WAIT_L(0); PG8_MMA(1, 0, At, B0); PG8_BAR; PG8_SCHED;
            PG8_STAGE(PG8_SB(1, 1), b3 + hstepB, voffB);
            PG8_WAIT_V(6); PG8_BAR; PG8_MMA(1, 1, At, B1); PG8_BAR;
            }
        }
        if constexpr (ALIGN_EPI) { if (wr == 0) PG8_BAR; }
        E(acc, cur, wr, wc, fr, fq, lds);
        if (!has_next) break;
#pragma unroll
        for (int a = 0; a < 2; ++a)
#pragma unroll
            for (int b = 0; b < 2; ++b)
#pragma unroll
                for (int m = 0; m < 4; ++m)
#pragma unroll
                    for (int n = 0; n < 2; ++n) acc[a][b][m][n] = (f32x4){0.f, 0.f, 0.f, 0.f};
        cur = nxt; cA = nA; cB = nB; ++ui;
        if constexpr (ALIGN_EPI) { if (wr == 1) PG8_BAR; }
    }
    PG8_WAIT_V(0);
    if constexpr (!ALIGN_EPI) { if (wr == 0) PG8_BAR; }
    PG8_BAR;
#undef PG8_SA
#undef PG8_SB
#undef PG8_STAGE
#undef PG8_LDA
#undef PG8_LDB
#undef PG8_MMA
#undef PG8_WAIT_V
#undef PG8_WAIT_L
#undef PG8_BAR
#undef PG8_SCHED
}
}

#ifndef PG8_SP2
#define PG8_SP2 true
#endif

struct TDesc { const float* W; bf16_t* WT; int K, N, row_off, item, scaled; };
__device__ __forceinline__ void p0_item_load(const TDesc& d, f32x4 (&v)[16], int lane) {
    const int nblk = d.N / 64, kb = d.item / nblk, nb = d.item % nblk, k0 = 64 * kb, n0 = 64 * nb;
    const int nn = (lane & 15) * 4;
#pragma unroll
    for (int i = 0; i < 16; ++i) { const int kk = 4 * i + (lane >> 4); v[i] = __builtin_nontemporal_load((const f32x4*)(d.W + (size_t)(k0 + kk) * d.N + n0 + nn)); }
}
__device__ __forceinline__ void p0_item_store(const TDesc& d, const f32x4 (&v)[16], LAS float* scr, int lane, const float* gs, const float* bs, float* c1, float* c2) {
    const int nblk = d.N / 64, kb = d.item / nblk, nb = d.item % nblk, k0 = 64 * kb, n0 = 64 * nb;
    const int nn = (lane & 15) * 4;
#pragma unroll
    for (int i = 0; i < 16; ++i) { const int kk = 4 * i + (lane >> 4); LAS float* q = scr + kk * 65 + nn; q[0] = v[i][0]; q[1] = v[i][1]; q[2] = v[i][2]; q[3] = v[i][3]; }
    asm volatile("s_waitcnt lgkmcnt(0)" ::: "memory");
    const int c = lane & 7;
    if (d.scaled) {
        const f32x4 ga = *(const f32x4*)(gs + k0 + 8 * c), gb = *(const f32x4*)(gs + k0 + 8 * c + 4), ba = *(const f32x4*)(bs + k0 + 8 * c), bb = *(const f32x4*)(bs + k0 + 8 * c + 4);
#pragma unroll
        for (int j = 0; j < 8; ++j) { const int n = (lane >> 3) + 8 * j; const LAS float* sp = scr + (8 * c) * 65 + n;
            const float w0 = sp[0 * 65], w1 = sp[1 * 65], w2 = sp[2 * 65], w3 = sp[3 * 65], w4 = sp[4 * 65], w5 = sp[5 * 65], w6 = sp[6 * 65], w7 = sp[7 * 65];
            u32x4 o; o.x = cvt_pk_bf16(w0 * ga[0], w1 * ga[1]); o.y = cvt_pk_bf16(w2 * ga[2], w3 * ga[3]); o.z = cvt_pk_bf16(w4 * gb[0], w5 * gb[1]); o.w = cvt_pk_bf16(w6 * gb[2], w7 * gb[3]);
            float s1 = ((bf_lo(o.x) + bf_hi(o.x)) + (bf_lo(o.y) + bf_hi(o.y))) + ((bf_lo(o.z) + bf_hi(o.z)) + (bf_lo(o.w) + bf_hi(o.w)));
            float s2 = ((w0 * ba[0] + w1 * ba[1]) + (w2 * ba[2] + w3 * ba[3])) + ((w4 * bb[0] + w5 * bb[1]) + (w6 * bb[2] + w7 * bb[3]));
            s1 += __shfl_xor(s1, 1); s1 += __shfl_xor(s1, 2); s1 += __shfl_xor(s1, 4); s2 += __shfl_xor(s2, 1); s2 += __shfl_xor(s2, 2); s2 += __shfl_xor(s2, 4);
            if (c == 0) { __hip_atomic_fetch_add(c1 + n0 + n, s1, __ATOMIC_RELAXED, __HIP_MEMORY_SCOPE_AGENT); __hip_atomic_fetch_add(c2 + n0 + n, s2, __ATOMIC_RELAXED, __HIP_MEMORY_SCOPE_AGENT); }
            *(u32x4*)(d.WT + (size_t)(d.row_off + n0 + n) * d.K + k0 + 8 * c) = o; }
    } else {
#pragma unroll
        for (int j = 0; j < 8; ++j) { const int n = (lane >> 3) + 8 * j; const LAS float* sp = scr + (8 * c) * 65 + n;
            u32x4 o; o.x = cvt_pk_bf16(sp[0 * 65], sp[1 * 65]); o.y = cvt_pk_bf16(sp[2 * 65], sp[3 * 65]); o.z = cvt_pk_bf16(sp[4 * 65], sp[5 * 65]); o.w = cvt_pk_bf16(sp[6 * 65], sp[7 * 65]);
            *(u32x4*)(d.WT + (size_t)(d.row_off + n0 + n) * d.K + k0 + 8 * c) = o; }
    }
    asm volatile("s_waitcnt lgkmcnt(0)" ::: "memory");
}

__device__ __forceinline__ void ln_rows_folded(const bf16_t* Z, const float* stats, const float* g2, const float* b2, const bf16_t* Y, float* O, const float* g, const float* b, int gw, int NGW, int lane) {
    for (int row = gw; row < T; row += NGW) {
        const f32x2 st = *(const f32x2*)(stats + 2 * (size_t)row);
        const float mean2 = st.x * (1.0f / D); const float rstd2 = 1.0f / sqrtf(fmaxf(st.y * (1.0f / D) - mean2 * mean2, 0.f) + LN_EPS);
        f32x4 v[8]; float s = 0.f;
#pragma unroll
        for (int j = 0; j < 8; ++j) {
            const u32x2 zw = *(const u32x2*)(Z + (size_t)row * D + 4 * lane + 256 * j); const u32x2 y = *(const u32x2*)(Y + (size_t)row * D + 4 * lane + 256 * j);
            const f32x4 g4 = *(const f32x4*)(g2 + 4 * lane + 256 * j), b4 = *(const f32x4*)(b2 + 4 * lane + 256 * j);
            const f32x4 z = {bf_lo(zw.x), bf_hi(zw.x), bf_lo(zw.y), bf_hi(zw.y)}; const f32x4 yy = {bf_lo(y.x), bf_hi(y.x), bf_lo(y.y), bf_hi(y.y)};
            v[j] = ((z - mean2) * rstd2 * g4 + b4) * ALPHA + yy;
            s += (v[j][0] + v[j][1]) + (v[j][2] + v[j][3]); }
        const float mean = wave_sum(s) * (1.0f / D); float s2 = 0.f;
#pragma unroll
        for (int j = 0; j < 8; ++j) { v[j] = v[j] - mean; s2 += (v[j][0] * v[j][0] + v[j][1] * v[j][1]) + (v[j][2] * v[j][2] + v[j][3] * v[j][3]); }
        const float rstd = 1.0f / sqrtf(wave_sum(s2) * (1.0f / D) + LN_EPS);
#pragma unroll
        for (int j = 0; j < 8; ++j) { const f32x4 g4 = *(const f32x4*)(g + 4 * lane + 256 * j), b4 = *(const f32x4*)(b + 4 * lane + 256 * j);
            __builtin_nontemporal_store(v[j] * rstd * g4 + b4, (f32x4*)(O + (size_t)row * D + 4 * lane + 256 * j)); }
    }
}
template <bool RBF>
__device__ __forceinline__ void ln_rows(const void* Rv, const bf16_t* Y, float* O, const float* g, const float* b, bf16_t* XBo, int gw, int NGW, int lane) {
    for (int row = gw; row < T; row += NGW) {
        const bf16_t* yr = Y + (size_t)row * D + 4 * lane;
        f32x4 v[8]; float s = 0.f;
#pragma unroll
        for (int j = 0; j < 8; ++j) {
            f32x4 r;
            if constexpr (RBF) { const u32x2 rw = *(const u32x2*)((const bf16_t*)Rv + (size_t)row * D + 4 * lane + 256 * j); r[0] = bf_lo(rw.x); r[1] = bf_hi(rw.x); r[2] = bf_lo(rw.y); r[3] = bf_hi(rw.y); }
            else r = __builtin_nontemporal_load((const f32x4*)((const float*)Rv + (size_t)row * D + 4 * lane + 256 * j));
            const u32x2 y = *(const u32x2*)(yr + 256 * j);
            v[j][0] = r[0] * ALPHA + bf_lo(y.x); v[j][1] = r[1] * ALPHA + bf_hi(y.x); v[j][2] = r[2] * ALPHA + bf_lo(y.y); v[j][3] = r[3] * ALPHA + bf_hi(y.y);
            s += (v[j][0] + v[j][1]) + (v[j][2] + v[j][3]); }
        const float mean = wave_sum(s) * (1.0f / D); float s2 = 0.f;
#pragma unroll
        for (int j = 0; j < 8; ++j) { v[j] = v[j] - mean; s2 += (v[j][0] * v[j][0] + v[j][1] * v[j][1]) + (v[j][2] * v[j][2] + v[j][3] * v[j][3]); }
        const float rstd = 1.0f / sqrtf(wave_sum(s2) * (1.0f / D) + LN_EPS);
#pragma unroll
        for (int j = 0; j < 8; ++j) { const f32x4 g4 = *(const f32x4*)(g + 4 * lane + 256 * j), b4 = *(const f32x4*)(b + 4 * lane + 256 * j);
            const f32x4 y = v[j] * rstd * g4 + b4;
            if (O) __builtin_nontemporal_store(y, (f32x4*)(O + (size_t)row * D + 4 * lane + 256 * j));
            if (XBo) { u32x2 w; w.x = cvt_pk_bf16(y[0], y[1]); w.y = cvt_pk_bf16(y[2], y[3]); *(u32x2*)(XBo + (size_t)row * D + 4 * lane + 256 * j) = w; } }
    }
}

#define XB_TMO      128
#define XB_XCNT(j)  (256  + 64 * (j))
#define XB_XSUB(j)  (1280 + 64 * (j))
#define XB_XGEN(j)  (2304 + 64 * (j))
#define XB_TOP      3328
#define XB_TOPGEN   3392
#define XCD_BAR_WORDS 3456
#define XB_SPIN_CAP (1u << 18)
__device__ __forceinline__ unsigned xb_ld(unsigned* p)              { return __hip_atomic_load(p, __ATOMIC_RELAXED, __HIP_MEMORY_SCOPE_AGENT); }
__device__ __forceinline__ unsigned xb_add(unsigned* p, unsigned v) { return __hip_atomic_fetch_add(p, v, __ATOMIC_RELAXED, __HIP_MEMORY_SCOPE_AGENT); }
__device__ __forceinline__ unsigned xb_xcc_id() { return (unsigned)__builtin_amdgcn_s_getreg((3 << 11) | 20) & 0xFu; }
#define XB_SPIN(cond, bar) do { unsigned _sp = 0; while (cond) { __builtin_amdgcn_s_sleep(1); \
    if ((++_sp & 255u) == 0u) { if (xb_ld(&(bar)[XB_TMO])) break; if (_sp > XB_SPIN_CAP) { atomicAdd(&(bar)[XB_TMO], 1u); break; } } } } while (0)
struct XcdBarrier { unsigned* bar; unsigned x; volatile LAS unsigned* st; };
__device__ __forceinline__ XcdBarrier xcd_barrier_post(unsigned* bar, volatile LAS unsigned* st) {
    XcdBarrier b; b.bar = bar; b.x = xb_xcc_id(); b.st = st;
    if (threadIdx.x == 0) (void)xb_add(&bar[XB_XCNT(b.x)], 1u);
    return b;
}
__device__ __forceinline__ void xcd_barrier_complete(unsigned* bar, unsigned x, unsigned& nloc, unsigned& nx) {
    const unsigned G = gridDim.x * gridDim.y * gridDim.z;
    unsigned sum, cnt, mine, sp = 0u;
    for (;;) {
        sum = 0u; cnt = 0u; mine = 0u;
#pragma unroll
        for (unsigned j = 0; j < 16; ++j) { const unsigned c = xb_ld(&bar[XB_XCNT(j)]); sum += c; cnt += (c > 0u) ? 1u : 0u; mine = (j == x) ? c : mine; }
        if (sum == G) break;
        __builtin_amdgcn_s_sleep(1);
        if ((++sp & 255u) == 0u) { if (xb_ld(&bar[XB_TMO])) break; if (sp > XB_SPIN_CAP) { atomicAdd(&bar[XB_TMO], 1u); break; } }
    }
    nloc = mine > 0u ? mine : 1u; nx = cnt > 0u ? cnt : 1u;
}
__device__ __forceinline__ void xcd_barrier(const XcdBarrier& b) {
    asm volatile("s_waitcnt vmcnt(0)" ::: "memory");
    __syncthreads();
    if (threadIdx.x == 0) {
        unsigned* bar = b.bar;
        __builtin_amdgcn_s_waitcnt(0);
        unsigned nloc = b.st[0], nx = b.st[1];
        if (nloc == 0u) { xcd_barrier_complete(bar, b.x, nloc, nx); b.st[0] = nloc; b.st[1] = nx; }
        const unsigned old = xb_add(&bar[XB_XSUB(b.x)], 1u);
        const unsigned gen = old / nloc;
        if (old + 1u == (gen + 1u) * nloc) {
            __builtin_amdgcn_fence(__ATOMIC_RELEASE, "agent");
            asm volatile("s_waitcnt vmcnt(0)" ::: "memory");
            const unsigned og = xb_add(&bar[XB_TOP], 1u);
            const unsigned tg = og / nx;
            if (og + 1u == (tg + 1u) * nx) xb_add(&bar[XB_TOPGEN], 1u);
            else XB_SPIN(xb_ld(&bar[XB_TOPGEN]) == tg, bar);
            __builtin_amdgcn_fence(__ATOMIC_ACQUIRE, "agent");
            xb_add(&bar[XB_XGEN(b.x)], 1u);
            asm volatile("s_waitcnt vmcnt(0)" ::: "memory");
        } else {
            XB_SPIN(xb_ld(&bar[XB_XGEN(b.x)]) == gen, bar);
            __builtin_amdgcn_fence(__ATOMIC_ACQUIRE, "agent");
            asm volatile("s_waitcnt vmcnt(0)" ::: "memory");
        }
    }
    __syncthreads();
}

struct Args { const float* in[26]; float* out; unsigned char* ws; int ph_lo, ph_hi; };
constexpr int N_PHASES = 15;

__global__ void __launch_bounds__(512, 2) fwd_mega(Args args) {
    extern __shared__ __attribute__((aligned(16))) unsigned char lds_raw[];
    LAS unsigned char* lds = (LAS unsigned char*)lds_raw;
    const int G = gridDim.x, bid = blockIdx.x;
    const int NGW = G * 8; const long NGT = (long)G * 512;
#define PHASE_IDS() int tid = threadIdx.x; asm volatile("" : "+v"(tid)); const int lane = tid & 63, wave = __builtin_amdgcn_readfirstlane(tid >> 6); \
    const int gw = bid * 8 + wave; const long gt = (long)bid * 512 + tid; (void)lane; (void)gw; (void)gt;
    unsigned char* ws = args.ws;
    const float* x = args.in[0]; const float* mem = args.in[1];
    bf16_t* WIN = (bf16_t*)(ws + WS_WIN); bf16_t* WOUT = (bf16_t*)(ws + WS_WOUT); bf16_t* WQ = (bf16_t*)(ws + WS_WQ); bf16_t* WK = (bf16_t*)(ws + WS_WK);
    bf16_t* WV = (bf16_t*)(ws + WS_WV); bf16_t* WO = (bf16_t*)(ws + WS_WO); bf16_t* WFF1 = (bf16_t*)(ws + WS_WFF1); bf16_t* WFF2 = (bf16_t*)(ws + WS_WFF2);
    bf16_t* WPOOL = (bf16_t*)(ws + WS_WPOOL); bf16_t* WAX = (bf16_t*)(ws + WS_WAX);
    bf16_t* MEMB = (bf16_t*)(ws + WS_MEMB); bf16_t* KB = (bf16_t*)(ws + WS_KB); bf16_t* VT = (bf16_t*)(ws + WS_VT);
    bf16_t* XB = (bf16_t*)(ws + WS_XB); unsigned short* BH = (unsigned short*)(ws + WS_BF); bf16_t* PROJ = (bf16_t*)(ws + WS_PROJ); bf16_t* Y3 = (bf16_t*)(ws + WS_Y3); bf16_t* QB = (bf16_t*)(ws + WS_Q); bf16_t* YB = (bf16_t*)(ws + WS_Q);
    bf16_t* PB = (bf16_t*)(ws + WS_PB); bf16_t* A2 = (bf16_t*)(ws + WS_A2); float* SUMP = (float*)(ws + WS_SUM); float* SUMH = SUMP + 4 * 64 * 1024;
    bf16_t* OB = (bf16_t*)(ws + WS_O); bf16_t* MIX = (bf16_t*)(ws + WS_MIX); unsigned short* AH = (unsigned short*)(ws + WS_AF); bf16_t* HB = (bf16_t*)(ws + WS_H);
    float* out = args.out;
    float* C1 = (float*)(ws + WS_CTL + CTL_C1); float* C2 = (float*)(ws + WS_CTL + CTL_C2); float* STATS2 = (float*)(ws + WS_CTL + CTL_STATS2);
    const int lo = args.ph_lo, hi = args.ph_hi;
#define IN(k) (lo <= (k) && (k) < hi)
#define SEAM(k) do { if (IN(k) && IN((k) + 1)) { xcd_barrier(bar); } } while (0)
    volatile LAS unsigned* bst = (volatile LAS unsigned*)(lds + LDS_BARST);
    if (threadIdx.x < 4) bst[threadIdx.x] = 0u;
    __syncthreads();
    XcdBarrier bar = xcd_barrier_post((unsigned*)(ws + WS_CTL) + 4096, bst);
    if (lo < -1) cg::this_grid().sync();

    if (IN(0)) for (int rep_ = 0; rep_ <= ((PROBE_DUP_MASK >> 0) & 1); ++rep_) {
        PHASE_IDS();
        LAS float* scr = (LAS float*)(lds + wave * 16640);
        constexpr int I_IN = 32 * 48, I_SQ = 32 * 32, I_F1 = 32 * 128, I_F2 = 128 * 32, I_POOL = 4 * 16, I_AX = 16 * 4;
        constexpr int NIT = I_IN + 5 * I_SQ + I_F1 + I_F2 + I_POOL + I_AX;
#define P0_RESOLVE(it_, d_) do { int r = (it_); \
            if (r < I_F1) { d_ = TDesc{args.in[22], WFF1, D, DFF, 0, r, 1}; break; } r -= I_F1; \
            if (r < I_F2) { d_ = TDesc{args.in[23], WFF2, DFF, D, 0, r, 0}; break; } r -= I_F2; \
            if (r < I_IN) { d_ = TDesc{args.in[2], WIN, D, NPROJ, 0, r, 0}; break; } r -= I_IN; \
            if (r < I_SQ) { d_ = TDesc{args.in[13], WOUT, D, D, 0, r, 0}; break; } r -= I_SQ; \
            if (r < I_SQ) { d_ = TDesc{args.in[16], WQ, D, D, 0, r, 0}; break; } r -= I_SQ; \
            if (r < I_SQ) { d_ = TDesc{args.in[17], WK, D, D, 0, r, 0}; break; } r -= I_SQ; \
            if (r < I_SQ) { d_ = TDesc{args.in[18], WV, D, D, 0, r, 0}; break; } r -= I_SQ; \
            if (r < I_SQ) { d_ = TDesc{args.in[19], WO, D, D, 0, r, 0}; break; } r -= I_SQ; \
            if (r < I_POOL) { const int g = r >> 4; d_ = TDesc{args.in[10] + (size_t)g * 65536, WPOOL + (size_t)g * 65536, 256, 256, 0, r & 15, 0}; break; } r -= I_POOL; \
            { const int mtx = r >> 2, h = mtx >> 1, which = mtx & 1;       \
              d_ = TDesc{args.in[which ? 7 : 5] + (size_t)h * 16384, WAX + (size_t)h * 32768, 128, 128, which * 128, r & 3, 0}; } } while (0)
        if (gw < NIT) {
            TDesc dc, dn; f32x4 vc[16], vn[16];
            P0_RESOLVE(gw, dc); p0_item_load(dc, vc, lane);
            for (int it = gw;;) {
                const int itn = it + NGW; const bool has_next = itn < NIT;
                if (has_next) { P0_RESOLVE(itn, dn); p0_item_load(dn, vn, lane); }
                p0_item_store(dc, vc, scr, lane, args.in[20], args.in[21], C1, C2);
                if (!has_next) break;
                dc = dn; it = itn;
#pragma unroll
                for (int i = 0; i < 16; ++i) vc[i] = vn[i];
            }
        }
#undef P0_RESOLVE
#pragma unroll 4
        for (long i = gt; i < (long)T * D / 8; i += NGT) { const f32x4 a = __builtin_nontemporal_load((const f32x4*)(x + i * 8)), b = __builtin_nontemporal_load((const f32x4*)(x + i * 8 + 4));
            u32x4 w; w.x = cvt_pk_bf16(a[0], a[1]); w.y = cvt_pk_bf16(a[2], a[3]); w.z = cvt_pk_bf16(b[0], b[1]); w.w = cvt_pk_bf16(b[2], b[3]); *(u32x4*)(XB + i * 8) = w; }
        for (long i = gt; i < (long)NMEMROWS * D / 8; i += NGT) { const f32x4 a = *(const f32x4*)(mem + i * 8), b = *(const f32x4*)(mem + i * 8 + 4);
            u32x4 w; w.x = cvt_pk_bf16(a[0], a[1]); w.y = cvt_pk_bf16(a[2], a[3]); w.z = cvt_pk_bf16(b[0], b[1]); w.w = cvt_pk_bf16(b[2], b[3]); *(u32x4*)(MEMB + i * 8) = w; }
        __syncthreads();
    }
    SEAM(0);

    if (IN(1)) for (int rep_ = 0; rep_ <= ((PROBE_DUP_MASK >> 1) & 1); ++rep_) {
        { pg8::GSched S; S.init(XB, D, WIN, D, 1, 64, 12, G, bid); pg8::EpiBf16 E{PROJ, NPROJ, 0, 0, 1, 0};
          pg8::gemm_phase<pg8::EpiBf16, pg8::GSched, true, PG8_SP2>(lds, D, S, E); }
    }
    SEAM(1);

    if (IN(2)) for (int rep_ = 0; rep_ <= ((PROBE_DUP_MASK >> 2) & 1); ++rep_) {
        PHASE_IDS();
        const float* conv_w = args.in[3]; const float* conv_b = args.in[4];
        for (long it = gt; it < (long)(T / 32) * 256; it += NGT) {
            const int chunk = (int)(it & 255), r0 = (int)(it >> 8) * 32, pos0 = r0 & (SEQ - 1);
            if (chunk < 128) {
                const int g = chunk >> 5, w = 2 << g;
                const bf16_t* p = PROJ + (size_t)r0 * NPROJ + chunk * 8;
                float s[8];
#pragma unroll
                for (int j = 0; j < 8; ++j) s[j] = 0.f;
                for (int k = 1; k < w; ++k) { if (pos0 - k >= 0) { const u32x4 v = *(const u32x4*)(p - (size_t)k * NPROJ);
                    s[0] += bf_lo(v.x); s[1] += bf_hi(v.x); s[2] += bf_lo(v.y); s[3] += bf_hi(v.y); s[4] += bf_lo(v.z); s[5] += bf_hi(v.z); s[6] += bf_lo(v.w); s[7] += bf_hi(v.w); } }
#pragma unroll 8
                for (int t = 0; t < 32; ++t) {
                    const int pos = pos0 + t;
                    const u32x4 v = *(const u32x4*)(p + (size_t)t * NPROJ);
                    const float u[8] = {bf_lo(v.x), bf_hi(v.x), bf_lo(v.y), bf_hi(v.y), bf_lo(v.z), bf_hi(v.z), bf_lo(v.w), bf_hi(v.w)};
#pragma unroll
                    for (int j = 0; j < 8; ++j) s[j] += u[j];
                    const int cnt = (pos + 1) < w ? (pos + 1) : w; const float inv = 1.0f / (float)cnt;
                    u32x4 o; o.x = cvt_pk_bf16(s[0] * inv - u[0], s[1] * inv - u[1]); o.y = cvt_pk_bf16(s[2] * inv - u[2], s[3] * inv - u[3]);
                    o.z = cvt_pk_bf16(s[4] * inv - u[4], s[5] * inv - u[5]); o.w = cvt_pk_bf16(s[6] * inv - u[6], s[7] * inv - u[7]);
                    *(u32x4*)(A2 + (size_t)(r0 + t) * D + chunk * 8) = o;
                    if (pos + 1 - w >= 0) { const u32x4 q = *(const u32x4*)(p + ((long)t + 1 - w) * NPROJ);
                        s[0] -= bf_lo(q.x); s[1] -= bf_hi(q.x); s[2] -= bf_lo(q.y); s[3] -= bf_hi(q.y); s[4] -= bf_lo(q.z); s[5] -= bf_hi(q.z); s[6] -= bf_lo(q.w); s[7] -= bf_hi(q.w); }
                }
            } else {
                const int c = (chunk - 128) * 8;
                const bf16_t* p = PROJ + (size_t)r0 * NPROJ + 1024 + c;
                float cw[4][8], cb[8];
#pragma unroll
                for (int k = 0; k < 4; ++k) { const f32x4 w0 = *(const f32x4*)(conv_w + k * 1024 + c), w1 = *(const f32x4*)(conv_w + k * 1024 + c + 4);
                    cw[k][0] = w0[0]; cw[k][1] = w0[1]; cw[k][2] = w0[2]; cw[k][3] = w0[3]; cw[k][4] = w1[0]; cw[k][5] = w1[1]; cw[k][6] = w1[2]; cw[k][7] = w1[3]; }
                { const f32x4 b0 = *(const f32x4*)(conv_b + c), b1 = *(const f32x4*)(conv_b + c + 4); cb[0] = b0[0]; cb[1] = b0[1]; cb[2] = b0[2]; cb[3] = b0[3]; cb[4] = b1[0]; cb[5] = b1[1]; cb[6] = b1[2]; cb[7] = b1[3]; }
                const u32x4 zero = {0u, 0u, 0u, 0u};
                u32x4 v0 = zero, v1 = zero, v2 = zero;
                if (pos0 > 0) { v0 = *(const u32x4*)(p - 3 * (size_t)NPROJ); v1 = *(const u32x4*)(p - 2 * (size_t)NPROJ); v2 = *(const u32x4*)(p - (size_t)NPROJ); }
#pragma unroll 8
                for (int t = 0; t < 32; ++t) {
                    const u32x4 v3 = *(const u32x4*)(p + (size_t)t * NPROJ);
                    float s[8];
#pragma unroll
                    for (int j = 0; j < 8; ++j) s[j] = cb[j];
#define CONV_TAP(k, v) s[0] += cw[k][0] * bf_lo(v.x); s[1] += cw[k][1] * bf_hi(v.x); s[2] += cw[k][2] * bf_lo(v.y); s[3] += cw[k][3] * bf_hi(v.y); \
                       s[4] += cw[k][4] * bf_lo(v.z); s[5] += cw[k][5] * bf_hi(v.z); s[6] += cw[k][6] * bf_lo(v.w); s[7] += cw[k][7] * bf_hi(v.w);
                    CONV_TAP(0, v0) CONV_TAP(1, v1) CONV_TAP(2, v2) CONV_TAP(3, v3)
#undef CONV_TAP
                    u32x4 o; o.x = cvt_pk_bf16(s[0], s[1]); o.y = cvt_pk_bf16(s[2], s[3]); o.z = cvt_pk_bf16(s[4], s[5]); o.w = cvt_pk_bf16(s[6], s[7]);
                    *(u32x4*)(A2 + (size_t)(r0 + t) * D + 1024 + c) = o;
                    v0 = v1; v1 = v2; v2 = v3;
                }
            }
        }
    }
    SEAM(2);

    if (IN(3)) for (int rep_ = 0; rep_ <= ((PROBE_DUP_MASK >> 3) & 1); ++rep_) {
        if (bid < 32) { pg8::GSched S; S.init(MEMB, D, WK, D, 1, 4, 8, 32, bid); pg8::EpiBf16 E{KB, D, 0, 0, 1, 0};
          pg8::gemm_phase<pg8::EpiBf16, pg8::GSched, true, PG8_SP2>(lds, D, S, E); }
        else if (bid < 64) { pg8::GSched S; S.init(WV, D, MEMB, D, 1, 8, 4, 32, bid - 32); pg8::EpiBf16 E{VT, NMEMROWS, 0, 0, 1, 0};
          pg8::gemm_phase<pg8::EpiBf16, pg8::GSched, true, PG8_SP2>(lds, D, S, E); }
        else {
        const int G2 = G - 64, c2 = bid - 64;
        { pg8::GSched S; S.init(A2, D, WPOOL, 256, 4, 64, 1, G2, c2); S.ga1 = 256; S.gb1 = 65536; pg8::EpiPool E{MIX, args.in[11], args.in[12]};
          pg8::gemm_phase<pg8::EpiPool, pg8::GSched, true, PG8_SP2>(lds, 256, S, E); }
        { pg8::GSched S; S.init(A2 + 1024, D, WAX, 128, 8, 64, 1, G2, (c2 + 128) % G2); S.ga1 = 128; S.gb1 = 32768; pg8::EpiLru E{A2, args.in[6], args.in[8], args.in[9], AH, BH};
          pg8::gemm_phase<pg8::EpiLru, pg8::GSched, true, PG8_SP2>(lds, 128, S, E); }
        }
    }
    SEAM(3);

    if (IN(4)) for (int rep_ = 0; rep_ <= ((PROBE_DUP_MASK >> 4) & 1); ++rep_) {
        PHASE_IDS();
        for (int it = (int)gt; it < 4 * 64 * 512; it += (int)NGT) {
            const int c2 = it & 511, k = (it >> 9) & 63, b = it >> 15;
            const size_t o0 = ((size_t)b * SEQ + k * 64) * 1024 + 2 * c2;
            const unsigned short* pa = AH + o0; const unsigned short* pb = BH + o0;
            float h0 = 0.f, h1 = 0.f, P0 = 1.f, P1 = 1.f;
#pragma unroll 8
            for (int t = 0; t < 64; ++t) { const unsigned dw = *(const unsigned*)(pa + (size_t)t * 1024), bw = *(const unsigned*)(pb + (size_t)t * 1024);
                const float a0 = 1.0f - h_lo(dw), a1 = 1.0f - h_hi(dw); h0 = a0 * h0 + h_lo(bw); h1 = a1 * h1 + h_hi(bw); P0 *= a0; P1 *= a1; }
            *(f32x2*)(SUMP + (size_t)(b * 64 + k) * 1024 + 2 * c2) = (f32x2){P0, P1}; *(f32x2*)(SUMH + (size_t)(b * 64 + k) * 1024 + 2 * c2) = (f32x2){h0, h1};
        }
    }
    SEAM(4);

    if (IN(5)) for (int rep_ = 0; rep_ <= ((PROBE_DUP_MASK >> 5) & 1); ++rep_) {
        PHASE_IDS();
        for (int it = (int)gt; it < 4 * 64 * 512; it += (int)NGT) {
            const int c2 = it & 511, k = (it >> 9) & 63, b = it >> 15;
            const float* sp = SUMP + (size_t)b * 65536 + 2 * c2; const float* sh = SUMH + (size_t)b * 65536 + 2 * c2;
            float h0 = 0.f, h1 = 0.f;
#pragma unroll 8
            for (int kk = 0; kk < k; ++kk) { const f32x2 p = *(const f32x2*)(sp + kk * 1024), q = *(const f32x2*)(sh + kk * 1024); h0 = h0 * p.x + q.x; h1 = h1 * p.y + q.y; }
            const size_t r0 = (size_t)b * SEQ + k * 64;
            const unsigned short* pa = AH + r0 * 1024 + 2 * c2; const unsigned short* pb = BH + r0 * 1024 + 2 * c2;
            const bf16_t* pg = PROJ + r0 * NPROJ + 2048 + 2 * c2; bf16_t* po = MIX + r0 * D + 1024 + 2 * c2;
#pragma unroll 8
            for (int t = 0; t < 64; ++t) { const unsigned dw = *(const unsigned*)(pa + (size_t)t * 1024), bw = *(const unsigned*)(pb + (size_t)t * 1024), gw2 = *(const unsigned*)(pg + (size_t)t * NPROJ);
                h0 = (1.0f - h_lo(dw)) * h0 + h_lo(bw); h1 = (1.0f - h_hi(dw)) * h1 + h_hi(bw);
                *(unsigned*)(po + (size_t)t * D) = cvt_pk_bf16(h0 * gelu_tanh(bf_lo(gw2)), h1 * gelu_tanh(bf_hi(gw2))); }
        }
    }
    SEAM(5);

    if (IN(6)) for (int rep_ = 0; rep_ <= ((PROBE_DUP_MASK >> 6) & 1); ++rep_) {
        pg8::GSched S; S.init(MIX, D, WOUT, D, 1, 64, 8, G, bid); pg8::EpiBf16 E{YB, D, 0, 0, 1, 0};
        pg8::gemm_phase<pg8::EpiBf16, pg8::GSched, true, PG8_SP2>(lds, D, S, E);
    }
    SEAM(6);
    if (IN(7)) for (int rep_ = 0; rep_ <= ((PROBE_DUP_MASK >> 7) & 1); ++rep_) { PHASE_IDS(); ln_rows<false>(x, YB, nullptr, args.in[14], args.in[15], XB, gw, NGW, lane); }
    SEAM(7);
    if (IN(8)) for (int rep_ = 0; rep_ <= ((PROBE_DUP_MASK >> 8) & 1); ++rep_) {
        pg8::GSched S; S.init(XB, D, WQ, D, 1, 64, 8, G, bid); pg8::EpiBf16 E{QB, D, 0, 0, 1, 0};
        pg8::gemm_phase<pg8::EpiBf16, pg8::GSched, true, PG8_SP2>(lds, D, S, E);
    }
    SEAM(8);
    if (IN(9)) for (int rep_ = 0; rep_ <= ((PROBE_DUP_MASK >> 9) & 1); ++rep_) {
        pg8::GSched S; S.init(QB, D, KB, D, 16, 16, 1, G, bid); S.gdiv = 4; S.ga1 = (long)SEQ * D; S.ga0 = 512; S.gb1 = 256L * D; S.gb0 = 512;
        pg8::EpiSoftmax E{PB, 0.04419417382415922f * 1.4426950408889634f};
        pg8::gemm_phase<pg8::EpiSoftmax, pg8::GSched, true, PG8_SP2>(lds, 512, S, E);
    }
    SEAM(9);
    if (IN(10)) for (int rep_ = 0; rep_ <= ((PROBE_DUP_MASK >> 10) & 1); ++rep_) {
        pg8::GSched S; S.init(PB, 256, VT, NMEMROWS, 16, 16, 2, G, bid); S.gdiv = 4; S.ga1 = 4L * SEQ * 256; S.ga0 = (long)SEQ * 256; S.gb1 = 256; S.gb0 = 512L * NMEMROWS;
        pg8::EpiBf16 E{OB, D, (long)SEQ * D, 512, 4, 0};
        pg8::gemm_phase<pg8::EpiBf16, pg8::GSched, true, PG8_SP2>(lds, 256, S, E);
    }
    SEAM(10);
    if (IN(11)) {
        pg8::GSched S; S.init(OB, D, WO, D, 1, 64, 8, G, bid); pg8::EpiResStat E{XB, STATS2};
        pg8::gemm_phase<pg8::EpiResStat, pg8::GSched, true, PG8_SP2>(lds, D, S, E);
    }
    SEAM(11);
    constexpr size_t CH_ROWS = T / 2;
    if (IN(13)) {
        { pg8::GSched S; S.init(XB, D, WFF1, D, 1, 32, 32, G, bid); S.wgm = 4; pg8::EpiFF1 E{HB, STATS2, C1, C2, 0};
          pg8::gemm_phase<pg8::EpiFF1, pg8::GSched, true, PG8_SP2>(lds, D, S, E); }
        xcd_barrier(bar);
        { pg8::GSched S; S.init(HB, DFF, WFF2, DFF, 1, 32, 8, G, bid); S.wgm = 4; pg8::EpiBf16 E{Y3, D, 0, 0, 1, 0};
          pg8::gemm_phase<pg8::EpiBf16, pg8::GSched, true, PG8_SP2>(lds, DFF, S, E); }
        { pg8::GSched S; S.init(XB + CH_ROWS * D, D, WFF1, D, 1, 32, 32, G, bid); S.wgm = 4; pg8::EpiFF1 E{HB + CH_ROWS * DFF, STATS2, C1, C2, (int)CH_ROWS};
          pg8::gemm_phase<pg8::EpiFF1, pg8::GSched, true, PG8_SP2>(lds, D, S, E); }
    }
    SEAM(13);
    if (IN(14)) {
        pg8::GSched S; S.init(HB + CH_ROWS * DFF, DFF, WFF2, DFF, 1, 32, 8, G, bid); S.wgm = 4; pg8::EpiBf16 E{Y3 + CH_ROWS * D, D, 0, 0, 1, 0};
        pg8::gemm_phase<pg8::EpiBf16, pg8::GSched, true, PG8_SP2>(lds, DFF, S, E);
    }
    SEAM(14);
    if (IN(15)) for (int rep_ = 0; rep_ <= ((PROBE_DUP_MASK >> 15) & 1); ++rep_) { PHASE_IDS(); ln_rows_folded(XB, STATS2, args.in[20], args.in[21], Y3, out, args.in[24], args.in[25], gw, NGW, lane); }
#undef IN
#undef SEAM
}

extern "C" void kernel_launch(void* const* d_in, const int* in_sizes, int n_in, void* d_out, int out_size, void* d_ws, size_t ws_size, hipStream_t stream) {
    static int grid = 0;
    if (grid == 0) {
        if (n_in != 26 || out_size != T * D || ws_size < WS_END) { fprintf(stderr, "kernel_launch: unexpected shapes (n_in %d out %d ws %zu)\n", n_in, out_size, ws_size); grid = -1; return; }
        int dev = 0, cus = 0, per_cu = 0;
        (void)hipGetDevice(&dev);
        (void)hipDeviceGetAttribute(&cus, hipDeviceAttributeMultiprocessorCount, dev);
        if (hipFuncSetAttribute((const void*)fwd_mega, hipFuncAttributeMaxDynamicSharedMemorySize, LDS_BYTES) != hipSuccess) { fprintf(stderr, "kernel_launch: hipFuncSetAttribute failed\n"); grid = -1; return; }
        if (hipOccupancyMaxActiveBlocksPerMultiprocessor(&per_cu, (const void*)fwd_mega, 512, LDS_BYTES) != hipSuccess || per_cu < 1) { fprintf(stderr, "kernel_launch: occupancy query says %d\n", per_cu); grid = -1; return; }
        grid = cus;
        if (grid % 8 != 0 || grid > 1024) { fprintf(stderr, "kernel_launch: unexpected CU count %d\n", cus); }
    }
    if (grid < 0) return;
    if (hipMemsetAsync((char*)d_ws + WS_CTL, 0, CTL_ZERO, stream) != hipSuccess) { fprintf(stderr, "kernel_launch: memset failed\n"); return; }
    Args a{};
    for (int i = 0; i < 26; ++i) a.in[i] = (const float*)d_in[i];
    a.out = (float*)d_out; a.ws = (unsigned char*)d_ws;
#if MK_N_LAUNCHES == 1
#if PROBE_PREFIX >= 0
    { a.ph_lo = 0; a.ph_hi = PROBE_PREFIX + 1; void* kargs0[] = {&a};
      (void)hipLaunchCooperativeKernel((const void*)fwd_mega, dim3(grid), dim3(512), kargs0, LDS_BYTES, stream);
      (void)hipMemsetAsync((char*)d_ws + WS_CTL, 0, CTL_ZERO, stream); }
#endif
    a.ph_lo = 0; a.ph_hi = N_PHASES + 1;
    void* kargs[] = {&a};
    hipError_t e = hipLaunchCooperativeKernel((const void*)fwd_mega, dim3(grid), dim3(512), kargs, LDS_BYTES, stream);
    if (e != hipSuccess) fprintf(stderr, "kernel_launch: cooperative launch failed: %s (grid %d)\n", hipGetErrorString(e), grid);
#else
    for (int p = 0; p <= N_PHASES; ++p) { a.ph_lo = p; a.ph_hi = p + 1; hipLaunchKernelGGL(fwd_mega, dim3(grid), dim3(512), LDS_BYTES, stream, a); }
#endif
}
```

```cpp
#include <hip/hip_runtime.h>
#include <hip/hip_cooperative_groups.h>
#include <cstdio>
#include <cstdint>
namespace cg = cooperative_groups;

#ifndef PROBE_DUP_MASK
#define PROBE_DUP_MASK 0
#endif
#ifndef PROBE_LN
#define PROBE_LN 0
#endif
#ifndef PROBE_PREFIX
#define PROBE_PREFIX -1
#endif
#ifndef MK_N_LAUNCHES
#define MK_N_LAUNCHES 1
#endif

#define LAS __attribute__((address_space(3)))
typedef unsigned short bf16_t;
typedef short bf16x8 __attribute__((ext_vector_type(8)));
typedef float f32x4 __attribute__((ext_vector_type(4)));
typedef float f32x2 __attribute__((ext_vector_type(2)));
typedef unsigned u32x4 __attribute__((ext_vector_type(4)));
typedef unsigned u32x2 __attribute__((ext_vector_type(2)));
typedef _Float16 f16x2 __attribute__((ext_vector_type(2)));

constexpr int T = 16384, SEQ = 4096, D = 2048, NPROJ = 3072, DFF = 8192, NMEMROWS = 1024;
constexpr float LN_EPS = 1e-5f;
constexpr float ALPHA = 1.189207115002721f;

constexpr size_t MiB = 1u << 20;
constexpr size_t WS_CTL = 0, CTL_BYTES = 1 * MiB;
constexpr size_t CTL_C1 = 64 * 1024, CTL_C2 = 96 * 1024, CTL_STATS2 = 128 * 1024, CTL_ZERO = 256 * 1024;
constexpr size_t WS_WFF1 = 2 * MiB, WS_WFF2 = 34 * MiB, WS_WIN = 66 * MiB, WS_WOUT = 78 * MiB, WS_WQ = 86 * MiB, WS_WK = 94 * MiB, WS_WV = 102 * MiB, WS_WO = 110 * MiB;
constexpr size_t WS_Y3 = 66 * MiB;
constexpr size_t WS_WPOOL = 118 * MiB, WS_WAX = 118 * MiB + 512 * 1024;
constexpr size_t WS_MEMB = 119 * MiB, WS_KB = 123 * MiB, WS_VT = 127 * MiB;
constexpr size_t WS_XB = 131 * MiB;
constexpr size_t WS_BF = 131 * MiB;
constexpr size_t WS_PROJ = 195 * MiB;
constexpr size_t WS_Q = 195 * MiB;
constexpr size_t WS_PB = 259 * MiB;
constexpr size_t WS_A2 = 291 * MiB;
constexpr size_t WS_SUM = 291 * MiB;
constexpr size_t WS_O = 291 * MiB;
constexpr size_t WS_MT = 295 * MiB;
constexpr size_t WS_NT = 311 * MiB;
constexpr size_t WS_MIX = 355 * MiB;
constexpr size_t WS_AF = 419 * MiB;
constexpr size_t WS_H = 195 * MiB;
constexpr size_t WS_END = 483 * MiB;

constexpr int LDS_BYTES = 147456;
constexpr int LDS_X = 131072;
constexpr int LDS_BARST = 131072 + 8192;

__device__ __forceinline__ unsigned cvt_pk_bf16(float lo, float hi) { unsigned r; asm volatile("v_cvt_pk_bf16_f32 %0, %1, %2" : "=v"(r) : "v"(lo), "v"(hi)); return r; }
__device__ __forceinline__ float bf_lo(unsigned w) { return __uint_as_float(w << 16); }
__device__ __forceinline__ float bf_hi(unsigned w) { return __uint_as_float(w & 0xffff0000u); }
__device__ __forceinline__ float bf2f(bf16_t b) { return __uint_as_float(((unsigned)b) << 16); }
__device__ __forceinline__ bf16_t f2bf(float f) { unsigned u = __float_as_uint(f); return (bf16_t)((u + 0x7fffu + ((u >> 16) & 1u)) >> 16); }
__device__ __forceinline__ float wave_sum(float v) {
#pragma unroll
    for (int o = 1; o < 64; o <<= 1) v += __shfl_xor(v, o);
    return v;
}
__device__ __forceinline__ unsigned pk_f16(float lo, float hi) { f16x2 v; v.x = (_Float16)lo; v.y = (_Float16)hi; return __builtin_bit_cast(unsigned, v); }
__device__ __forceinline__ float h_lo(unsigned w) { return (float)__builtin_bit_cast(f16x2, w).x; }
__device__ __forceinline__ float h_hi(unsigned w) { return (float)__builtin_bit_cast(f16x2, w).y; }
__device__ __forceinline__ float sigmoidf_(float x) { return 1.0f / (1.0f + __expf(-x)); }
__device__ __forceinline__ float gelu_tanh(float x) {
    const float z = 0.7978845608028654f * (x + 0.044715f * x * x * x);
    const float e = __expf(2.0f * z);
    const float th = 1.0f - 2.0f / (e + 1.0f);
    return 0.5f * x * (1.0f + th);
}

namespace pg8 {
constexpr int BM = 256, BK = 64, HALF = 128, HTB = HALF * BK * 2, STAGE_BYTES = 8 * HTB, NXCD = 8, WGM = 8;
__host__ __device__ __forceinline__ int lds_byte(int r, int c) { const int st = (r >> 4) * 2 + (c >> 5), rr = r & 15, cc = c & 31, ob = rr * 64 + cc * 2; return st * 1024 + (ob ^ (((ob >> 9) & 1) << 5)); }
__host__ __device__ __forceinline__ void stage_rc(int b, int& R, int& C) { const int st = b / 1024, sb = b % 1024, swz = sb ^ (((sb >> 9) & 1) << 5); R = (st >> 1) * 16 + swz / 64; C = (st & 1) * 32 + (swz % 64) / 2; }
__host__ __device__ __forceinline__ int perm32(int rho) { const int n = rho >> 4, i = rho & 15; return 8 * (i >> 2) + 4 * n + (i & 3); }

struct Unit { int pm, pn, g; };

struct GSched {
    const bf16_t* A; const bf16_t* Bt;
    long ga1, ga0, gb1, gb0; int gdiv;
    int lda, ldb, nMg, nVM, nN, nwg, G, c, wgm;
    __device__ __forceinline__ void init(const bf16_t* A_, int lda_, const bf16_t* Bt_, int ldb_, int nG, int nMg_, int nN_, int G_, int c_) {
        A = A_; Bt = Bt_; lda = lda_; ldb = ldb_; nMg = nMg_; nVM = nG * nMg_; nN = nN_; nwg = nVM * nN_; G = G_; c = c_;
        ga1 = ga0 = gb1 = gb0 = 0; gdiv = 1; wgm = WGM;
    }
    __device__ __forceinline__ bool next(int i, Unit& u) const {
        const long L = (long)i * G + c; if (L >= nwg) return false;
        int wgid = (int)L; { const int q = nwg / NXCD, r = nwg % NXCD, xcd = wgid % NXCD, off = wgid / NXCD; wgid = (xcd < r ? xcd * (q + 1) : r * (q + 1) + (xcd - r) * q) + off; }
        const int nig = wgm * nN, gid = wgid / nig, fm = gid * wgm, gsz = (nVM - fm) < wgm ? (nVM - fm) : wgm;
        const int vm = fm + ((wgid % nig) % gsz); u.pn = (wgid % nig) / gsz; u.g = vm / nMg; u.pm = vm % nMg; return true;
    }
    __device__ __forceinline__ const char* a_ptr(const Unit& u) const { return (const char*)(A + (long)(u.g / gdiv) * ga1 + (long)(u.g % gdiv) * ga0 + (long)u.pm * BM * lda); }
    __device__ __forceinline__ const char* b_ptr(const Unit& u) const { return (const char*)(Bt + (long)(u.g / gdiv) * gb1 + (long)(u.g % gdiv) * gb0 + (long)u.pn * BM * ldb); }
};

struct EpiBf16 {
    static constexpr bool PERM = true;
    bf16_t* O; int ldc; long go1, go0; int gdiv; int act;
    __device__ __forceinline__ void operator()(f32x4 (&acc)[2][2][4][2], const Unit& u, int wr, int wc, int fr, int fq, LAS unsigned char*) const {
        bf16_t* base = O + (long)(u.g / gdiv) * go1 + (long)(u.g % gdiv) * go0 + ((size_t)u.pm * BM + wr * 64 + fr) * ldc + u.pn * BM + wc * 32 + 8 * fq;
#pragma unroll
        for (int ai = 0; ai < 2; ++ai)
#pragma unroll
            for (int m = 0; m < 4; ++m) { bf16_t* rowp = base + (size_t)(ai * HALF + m * 16) * ldc;
#pragma unroll
                for (int bj = 0; bj < 2; ++bj) { f32x4 v0 = acc[ai][bj][m][0], v1 = acc[ai][bj][m][1];
                    if (act == 1) {
#pragma unroll
                        for (int j = 0; j < 4; ++j) { const float a0 = fmaxf(v0[j], 0.f), a1 = fmaxf(v1[j], 0.f); v0[j] = a0 * a0; v1[j] = a1 * a1; } }
                    u32x4 w; w.x = cvt_pk_bf16(v0[0], v0[1]); w.y = cvt_pk_bf16(v0[2], v0[3]); w.z = cvt_pk_bf16(v1[0], v1[1]); w.w = cvt_pk_bf16(v1[2], v1[3]);
                    *(u32x4*)(rowp + bj * HALF) = w; } }
    }
};
struct EpiResStat {
    static constexpr bool PERM = true;
    bf16_t* X; float* stats; int rpg;
    __device__ __forceinline__ void operator()(f32x4 (&acc)[2][2][4][2], const Unit& u, int wr, int wc, int fr, int fq, LAS unsigned char*) const {
        const int pmg = u.g * rpg + u.pm;
        bf16_t* base = X + ((size_t)pmg * BM + wr * 64 + fr) * D + u.pn * BM + wc * 32 + 8 * fq;
        u32x4 xr[2][4][2];
#pragma unroll
        for (int ai = 0; ai < 2; ++ai)
#pragma unroll
            for (int m = 0; m < 4; ++m)
#pragma unroll
                for (int bj = 0; bj < 2; ++bj) xr[ai][m][bj] = *(const u32x4*)(base + (size_t)(ai * HALF + m * 16) * D + bj * HALF);
#pragma unroll
        for (int ai = 0; ai < 2; ++ai)
#pragma unroll
            for (int m = 0; m < 4; ++m) { float s = 0.f, q = 0.f;
#pragma unroll
                for (int bj = 0; bj < 2; ++bj) { const u32x4 x = xr[ai][m][bj]; const f32x4 a0 = acc[ai][bj][m][0], a1 = acc[ai][bj][m][1];
                    u32x4 w; w.x = cvt_pk_bf16(bf_lo(x.x) * ALPHA + a0[0], bf_hi(x.x) * ALPHA + a0[1]); w.y = cvt_pk_bf16(bf_lo(x.y) * ALPHA + a0[2], bf_hi(x.y) * ALPHA + a0[3]);
                    w.z = cvt_pk_bf16(bf_lo(x.z) * ALPHA + a1[0], bf_hi(x.z) * ALPHA + a1[1]); w.w = cvt_pk_bf16(bf_lo(x.w) * ALPHA + a1[2], bf_hi(x.w) * ALPHA + a1[3]);
                    const float z[8] = {bf_lo(w.x), bf_hi(w.x), bf_lo(w.y), bf_hi(w.y), bf_lo(w.z), bf_hi(w.z), bf_lo(w.w), bf_hi(w.w)};
#pragma unroll
                    for (int e = 0; e < 8; ++e) { s += z[e]; q += z[e] * z[e]; }
                    *(u32x4*)(base + (size_t)(ai * HALF + m * 16) * D + bj * HALF) = w; }
                s += __shfl_xor(s, 16); s += __shfl_xor(s, 32); q += __shfl_xor(q, 16); q += __shfl_xor(q, 32);
                if (fq == 0) { float* st = stats + 2 * ((size_t)pmg * BM + ai * HALF + wr * 64 + m * 16 + fr);
                    __hip_atomic_fetch_add(st, s, __ATOMIC_RELAXED, __HIP_MEMORY_SCOPE_AGENT); __hip_atomic_fetch_add(st + 1, q, __ATOMIC_RELAXED, __HIP_MEMORY_SCOPE_AGENT); } }
    }
};
struct EpiFF1 {
    static constexpr bool PERM = true;
    bf16_t* O; const float* stats; const float* c1; const float* c2; int row0;
    __device__ __forceinline__ void operator()(f32x4 (&acc)[2][2][4][2], const Unit& u, int wr, int wc, int fr, int fq, LAS unsigned char*) const {
        const int col0 = u.pn * BM + wc * 32 + 8 * fq;
        bf16_t* base = O + ((size_t)u.pm * BM + wr * 64 + fr) * DFF + col0;
        f32x4 c1v[2][2], c2v[2][2];
#pragma unroll
        for (int bj = 0; bj < 2; ++bj)
#pragma unroll
            for (int n = 0; n < 2; ++n) { c1v[bj][n] = *(const f32x4*)(c1 + col0 + bj * HALF + 4 * n); c2v[bj][n] = *(const f32x4*)(c2 + col0 + bj * HALF + 4 * n); }
        f32x2 st[2][4];
#pragma unroll
        for (int ai = 0; ai < 2; ++ai)
#pragma unroll
            for (int m = 0; m < 4; ++m) st[ai][m] = *(const f32x2*)(stats + 2 * ((size_t)row0 + (size_t)u.pm * BM + ai * HALF + wr * 64 + m * 16 + fr));
#pragma unroll
        for (int ai = 0; ai < 2; ++ai)
#pragma unroll
            for (int m = 0; m < 4; ++m) { bf16_t* rowp = base + (size_t)(ai * HALF + m * 16) * DFF;
                const float mean = st[ai][m].x * (1.0f / D); const float var = fmaxf(st[ai][m].y * (1.0f / D) - mean * mean, 0.f); const float rstd = 1.0f / sqrtf(var + LN_EPS);
#pragma unroll
                for (int bj = 0; bj < 2; ++bj) { f32x4 v0 = (acc[ai][bj][m][0] - c1v[bj][0] * mean) * rstd + c2v[bj][0], v1 = (acc[ai][bj][m][1] - c1v[bj][1] * mean) * rstd + c2v[bj][1];
#pragma unroll
                    for (int j = 0; j < 4; ++j) { const float a0 = fmaxf(v0[j], 0.f), a1 = fmaxf(v1[j], 0.f); v0[j] = a0 * a0; v1[j] = a1 * a1; }
                    u32x4 w; w.x = cvt_pk_bf16(v0[0], v0[1]); w.y = cvt_pk_bf16(v0[2], v0[3]); w.z = cvt_pk_bf16(v1[0], v1[1]); w.w = cvt_pk_bf16(v1[2], v1[3]);
                    *(u32x4*)(rowp + bj * HALF) = w; } }
    }
};
struct EpiPool {
    static constexpr bool PERM = true;
    bf16_t* O; const float* bias; const float* scale;
    __device__ __forceinline__ void operator()(f32x4 (&acc)[2][2][4][2], const Unit& u, int wr, int wc, int fr, int fq, LAS unsigned char*) const {
        const int col0 = u.g * 256 + wc * 32 + 8 * fq;
        bf16_t* base = O + ((size_t)u.pm * BM + wr * 64 + fr) * D + col0;
        f32x4 bv[2][2], sv[2][2];
#pragma unroll
        for (int bj = 0; bj < 2; ++bj)
#pragma unroll
            for (int n = 0; n < 2; ++n) { bv[bj][n] = *(const f32x4*)(bias + col0 + bj * HALF + 4 * n); sv[bj][n] = *(const f32x4*)(scale + col0 + bj * HALF + 4 * n); }
#pragma unroll
        for (int ai = 0; ai < 2; ++ai)
#pragma unroll
            for (int m = 0; m < 4; ++m) { bf16_t* rowp = base + (size_t)(ai * HALF + m * 16) * D;
#pragma unroll
                for (int bj = 0; bj < 2; ++bj) { const f32x4 v0 = (acc[ai][bj][m][0] + bv[bj][0]) * sv[bj][0], v1 = (acc[ai][bj][m][1] + bv[bj][1]) * sv[bj][1];
                    u32x4 w; w.x = cvt_pk_bf16(v0[0], v0[1]); w.y = cvt_pk_bf16(v0[2], v0[3]); w.z = cvt_pk_bf16(v1[0], v1[1]); w.w = cvt_pk_bf16(v1[2], v1[3]);
                    *(u32x4*)(rowp + bj * HALF) = w; } }
    }
};
struct EpiLru {
    static constexpr bool PERM = true;
    const bf16_t* A2; const float* b_a; const float* b_x; const float* lam; unsigned short* AH; unsigned short* BH;
    __device__ __forceinline__ void operator()(f32x4 (&acc)[2][2][4][2], const Unit& u, int wr, int wc, int fr, int fq, LAS unsigned char*) const {
        const int ch0 = u.g * 128 + wc * 32 + 8 * fq;
        f32x4 ba[2], bx[2], nsp[2];
#pragma unroll
        for (int n = 0; n < 2; ++n) { ba[n] = *(const f32x4*)(b_a + ch0 + 4 * n); bx[n] = *(const f32x4*)(b_x + ch0 + 4 * n); const f32x4 l = *(const f32x4*)(lam + ch0 + 4 * n);
#pragma unroll
            for (int j = 0; j < 4; ++j) nsp[n][j] = -8.0f * log1pf(__expf(-l[j])); }
        u32x4 xw[2][4];
#pragma unroll
        for (int ai = 0; ai < 2; ++ai)
#pragma unroll
            for (int m = 0; m < 4; ++m) { const int row = u.pm * BM + ai * HALF + wr * 64 + m * 16 + fr; xw[ai][m] = *(const u32x4*)(A2 + (size_t)row * D + 1024 + ch0); }
#pragma unroll
        for (int ai = 0; ai < 2; ++ai)
#pragma unroll
            for (int m = 0; m < 4; ++m) { const int row = u.pm * BM + ai * HALF + wr * 64 + m * 16 + fr; const bool first = (row & (SEQ - 1)) == 0;
                const float xc[2][4] = {{bf_lo(xw[ai][m].x), bf_hi(xw[ai][m].x), bf_lo(xw[ai][m].y), bf_hi(xw[ai][m].y)}, {bf_lo(xw[ai][m].z), bf_hi(xw[ai][m].z), bf_lo(xw[ai][m].w), bf_hi(xw[ai][m].w)}};
                float dv[2][4], bv[2][4];
#pragma unroll
                for (int n = 0; n < 2; ++n)
#pragma unroll
                    for (int j = 0; j < 4; ++j) {
                        const float r = sigmoidf_(acc[ai][0][m][n][j] + ba[n][j]);
                        const float ig = sigmoidf_(acc[ai][1][m][n][j] + bx[n][j]);
                        const float la = nsp[n][j] * r;
                        const float a = __expf(la);
                        const float mult = first ? 1.0f : sqrtf(fmaxf(1.0f - a * a, 0.f));
                        dv[n][j] = 1.0f - a; bv[n][j] = mult * ig * xc[n][j]; }
                u32x4 dw, bw;
                dw.x = pk_f16(dv[0][0], dv[0][1]); dw.y = pk_f16(dv[0][2], dv[0][3]); dw.z = pk_f16(dv[1][0], dv[1][1]); dw.w = pk_f16(dv[1][2], dv[1][3]);
                bw.x = pk_f16(bv[0][0], bv[0][1]); bw.y = pk_f16(bv[0][2], bv[0][3]); bw.z = pk_f16(bv[1][0], bv[1][1]); bw.w = pk_f16(bv[1][2], bv[1][3]);
                *(u32x4*)(AH + (size_t)row * 1024 + ch0) = dw; *(u32x4*)(BH + (size_t)row * 1024 + ch0) = bw; }
    }
};
struct EpiSoftmax {
    static constexpr bool PERM = true;
    bf16_t* P; float scale_log2e;
    __device__ __forceinline__ void operator()(f32x4 (&acc)[2][2][4][2], const Unit& u, int wr, int wc, int fr, int fq, LAS unsigned char* lds) const {
        LAS f32x2* X = (LAS f32x2*)(lds + LDS_X);
        float mxs[2][4];
#pragma unroll
        for (int ai = 0; ai < 2; ++ai)
#pragma unroll
            for (int m = 0; m < 4; ++m) {
                float mx = -3.0e38f;
#pragma unroll
                for (int bj = 0; bj < 2; ++bj)
#pragma unroll
                    for (int n = 0; n < 2; ++n) { acc[ai][bj][m][n] = acc[ai][bj][m][n] * scale_log2e; const f32x4 x = acc[ai][bj][m][n]; mx = fmaxf(mx, fmaxf(fmaxf(x[0], x[1]), fmaxf(x[2], x[3]))); }
                mx = fmaxf(mx, __shfl_xor(mx, 16)); mx = fmaxf(mx, __shfl_xor(mx, 32));
                float s = 0.f;
#pragma unroll
                for (int bj = 0; bj < 2; ++bj)
#pragma unroll
                    for (int n = 0; n < 2; ++n) { f32x4 x = acc[ai][bj][m][n];
#pragma unroll
                        for (int j = 0; j < 4; ++j) { x[j] = __builtin_amdgcn_exp2f(x[j] - mx); s += x[j]; }
                        acc[ai][bj][m][n] = x; }
                s += __shfl_xor(s, 16); s += __shfl_xor(s, 32);
                mxs[ai][m] = mx;
                if (fq == 0) X[(ai * HALF + wr * 64 + m * 16 + fr) * 4 + wc] = (f32x2){mx, s};
            }
        asm volatile("s_waitcnt lgkmcnt(0)" ::: "memory"); __builtin_amdgcn_s_barrier(); asm volatile("" ::: "memory");
        bf16_t* base = P + ((size_t)(u.g >> 2) * SEQ + (size_t)u.pm * BM + wr * 64 + fr) * 1024 + (u.g & 3) * 256 + wc * 32 + 8 * fq;
#pragma unroll
        for (int ai = 0; ai < 2; ++ai)
#pragma unroll
            for (int m = 0; m < 4; ++m) { const int r = ai * HALF + wr * 64 + m * 16 + fr;
                const f32x2 p0 = X[r * 4 + 0], p1 = X[r * 4 + 1], p2 = X[r * 4 + 2], p3 = X[r * 4 + 3];
                const float M = fmaxf(fmaxf(p0.x, p1.x), fmaxf(p2.x, p3.x));
                const float tot = p0.y * __builtin_amdgcn_exp2f(p0.x - M) + p1.y * __builtin_amdgcn_exp2f(p1.x - M) + p2.y * __builtin_amdgcn_exp2f(p2.x - M) + p3.y * __builtin_amdgcn_exp2f(p3.x - M);
                const float f = __builtin_amdgcn_exp2f(mxs[ai][m] - M) / tot;
                bf16_t* rowp = base + (size_t)(ai * HALF + m * 16) * 1024;
#pragma unroll
                for (int bj = 0; bj < 2; ++bj) { const f32x4 v0 = acc[ai][bj][m][0] * f, v1 = acc[ai][bj][m][1] * f;
                    u32x4 w; w.x = cvt_pk_bf16(v0[0], v0[1]); w.y = cvt_pk_bf16(v0[2], v0[3]); w.z = cvt_pk_bf16(v1[0], v1[1]); w.w = cvt_pk_bf16(v1[2], v1[3]);
                    *(u32x4*)(rowp + bj * HALF) = w; } }
    }
};

template <class Epi, class Sched, bool ALIGN_EPI, bool SP2>
__device__ __forceinline__ void gemm_phase(LAS unsigned char* lds, const int K_, const Sched& S, const Epi& E) {
    int K = K_; asm volatile("" : "+s"(K));
    int tid_ = threadIdx.x; asm volatile("" : "+v"(tid_));
    const int tid = tid_, wid = __builtin_amdgcn_readfirstlane(tid >> 6), lane = tid & 63, wr = wid >> 2, wc = wid & 3, fr = lane & 15, fq = lane >> 4;
    const int nt = K / BK;
    unsigned voffA[2], voffB[2];
#pragma unroll
    for (int i = 0; i < 2; ++i) { int R, C; stage_rc(tid * 16 + i * 8192, R, C); const int Rb = Epi::PERM ? ((R & ~31) + perm32(R & 31)) : R;
        voffA[i] = (unsigned)(R * S.lda + C) * 2u; voffB[i] = (unsigned)(Rb * S.ldb + C) * 2u; }
    const size_t kstep = (size_t)(BK * 2);
    const size_t hstepA = (size_t)HALF * S.lda * 2, hstepB = (size_t)HALF * S.ldb * 2;
    const unsigned ldsw = (unsigned)wid * 1024u;
    const int aoff = lds_byte(wr * 64 + fr, fq * 8), boff = lds_byte(wc * 32 + fr, fq * 8);
#define PG8_SA(b, h) (((b) * 2 + (h)) * HTB)
#define PG8_SB(b, h) ((4 + (b) * 2 + (h)) * HTB)
#define PG8_STAGE(bufoff, gbase, voff) do { _Pragma("unroll") for (int _i = 0; _i < 2; ++_i) \
        __builtin_amdgcn_global_load_lds((const unsigned*)((const char*)(gbase) + (voff)[_i]), (LAS unsigned*)(lds + (bufoff) + ldsw + _i * 8192), 16, 0, 0); } while (0)
#define PG8_LDA(dst, b, h) do { _Pragma("unroll") for (int m = 0; m < 4; ++m) _Pragma("unroll") for (int k = 0; k < 2; ++k) dst[m][k] = *(const LAS bf16x8*)(lds + PG8_SA(b, h) + aoff + m * 2048 + k * 1024); } while (0)
#define PG8_LDB(dst, b, h) do { _Pragma("unroll") for (int n = 0; n < 2; ++n) _Pragma("unroll") for (int k = 0; k < 2; ++k) dst[n][k] = *(const LAS bf16x8*)(lds + PG8_SB(b, h) + boff + n * 2048 + k * 1024); } while (0)
#define PG8_MMA(ai, bj, At, Bt) do { __builtin_amdgcn_s_setprio(1); _Pragma("unroll") for (int m = 0; m < 4; ++m) _Pragma("unroll") for (int n = 0; n < 2; ++n) _Pragma("unroll") for (int k = 0; k < 2; ++k) \
        acc[ai][bj][m][n] = __builtin_amdgcn_mfma_f32_16x16x32_bf16(Bt[n][k], At[m][k], acc[ai][bj][m][n], 0, 0, 0); __builtin_amdgcn_s_setprio(0); } while (0)
#define PG8_WAIT_V(n) asm volatile("s_waitcnt vmcnt(" #n ")" ::: "memory")
#define PG8_WAIT_L(n) asm volatile("s_waitcnt lgkmcnt(" #n ")" ::: "memory")
#define PG8_BAR __builtin_amdgcn_s_barrier()
#define PG8_SCHED __builtin_amdgcn_sched_barrier(0)
    Unit cur, nxt; int ui = 0;
    if (!S.next(0, cur)) return;
    f32x4 acc[2][2][4][2];
#pragma unroll
    for (int a = 0; a < 2; ++a)
#pragma unroll
        for (int b = 0; b < 2; ++b)
#pragma unroll
            for (int m = 0; m < 4; ++m)
#pragma unroll
                for (int n = 0; n < 2; ++n) acc[a][b][m][n] = (f32x4){0.f, 0.f, 0.f, 0.f};
    bf16x8 At[4][2], B0[2][2], B1[2][2];
    const char* cA = S.a_ptr(cur); const char* cB = S.b_ptr(cur);
    if constexpr (SP2) {
        PG8_STAGE(PG8_SB(0, 0), cB, voffB); PG8_STAGE(PG8_SB(0, 1), cB + hstepB, voffB); PG8_STAGE(PG8_SA(0, 0), cA, voffA); PG8_STAGE(PG8_SA(0, 1), cA + hstepA, voffA);
        if (wr == 1) PG8_BAR;
        PG8_WAIT_V(2); PG8_BAR;
        PG8_STAGE(PG8_SB(1, 0), cB + kstep, voffB); PG8_STAGE(PG8_SA(1, 0), cA + kstep, voffA); PG8_STAGE(PG8_SB(1, 1), cB + hstepB + kstep, voffB);
        PG8_WAIT_V(6); PG8_BAR;
    } else {
        PG8_STAGE(PG8_SB(0, 0), cB, voffB); PG8_STAGE(PG8_SA(0, 0), cA, voffA); PG8_STAGE(PG8_SB(0, 1), cB + hstepB, voffB); PG8_STAGE(PG8_SA(0, 1), cA + hstepA, voffA);
        if (wr == 1) PG8_BAR;
        PG8_WAIT_V(4); PG8_BAR;
        PG8_STAGE(PG8_SB(1, 0), cB + kstep, voffB); PG8_STAGE(PG8_SA(1, 0), cA + kstep, voffA); PG8_STAGE(PG8_SB(1, 1), cB + hstepB + kstep, voffB);
        PG8_WAIT_V(6); PG8_BAR;
    }
    for (;;) {
        const bool has_next = S.next(ui + 1, nxt);
        const char* nA = has_next ? S.a_ptr(nxt) : cA; const char* nB = has_next ? S.b_ptr(nxt) : cB;
        for (int t = 0; t < nt; t += 2) {
            const bool last = (t == nt - 2);
            const char* a1 = cA + (size_t)(t + 1) * kstep;
            const char* a2 = last ? nA : cA + (size_t)(t + 2) * kstep; const char* b2 = last ? nB : cB + (size_t)(t + 2) * kstep;
            const char* a3 = a2 + kstep; const char* b3 = b2 + kstep;
            if constexpr (SP2) {
            PG8_LDB(B0, 0, 0); PG8_LDB(B1, 0, 1); PG8_SCHED; PG8_LDA(At, 0, 0); PG8_STAGE(PG8_SA(1, 1), a1 + hstepA, voffA);
            PG8_WAIT_V(8); PG8_WAIT_L(0); PG8_BAR; PG8_MMA(0, 0, At, B0); PG8_MMA(0, 1, At, B1); PG8_BAR; PG8_SCHED;
            PG8_LDA(At, 0, 1); PG8_STAGE(PG8_SB(0, 0), b2, voffB); PG8_STAGE(PG8_SB(0, 1), b2 + hstepB, voffB); PG8_STAGE(PG8_SA(0, 0), a2, voffA);
            PG8_WAIT_V(8); PG8_WAIT_L(0); PG8_BAR; PG8_MMA(1, 0, At, B0); PG8_MMA(1, 1, At, B1); PG8_BAR; PG8_SCHED;
            PG8_LDB(B0, 1, 0); PG8_LDB(B1, 1, 1); PG8_SCHED; PG8_LDA(At, 1, 0); PG8_STAGE(PG8_SA(0, 1), a2 + hstepA, voffA);
            PG8_WAIT_V(8); PG8_WAIT_L(0); PG8_BAR; PG8_MMA(0, 0, At, B0); PG8_MMA(0, 1, At, B1); PG8_BAR; PG8_SCHED;
            PG8_LDA(At, 1, 1); PG8_STAGE(PG8_SB(1, 0), b3, voffB); PG8_STAGE(PG8_SB(1, 1), b3 + hstepB, voffB); PG8_STAGE(PG8_SA(1, 0), a3, voffA);
            PG8_WAIT_V(8); PG8_WAIT_L(0); PG8_BAR; PG8_MMA(1, 0, At, B0); PG8_MMA(1, 1, At, B1); PG8_BAR; PG8_SCHED;
            } else {
            PG8_LDB(B0, 0, 0); PG8_SCHED; PG8_LDA(At, 0, 0); PG8_STAGE(PG8_SA(1, 1), a1 + hstepA, voffA);
            PG8_WAIT_L(8); PG8_BAR; PG8_WAIT_L(0); PG8_MMA(0, 0, At, B0); PG8_BAR; PG8_SCHED;
            PG8_LDB(B1, 0, 1); PG8_STAGE(PG8_SB(0, 0), b2, voffB);
            PG8_BAR; PG8_WAIT_L(0); PG8_MMA(0, 1, At, B1); PG8_BAR;
            PG8_LDA(At, 0, 1); PG8_STAGE(PG8_SA(0, 0), a2, voffA);
            PG8_BAR; PG8_WAIT_L(0); PG8_MMA(1, 0, At, B0); PG8_BAR; PG8_SCHED;
            PG8_STAGE(PG8_SB(0, 1), b2 + hstepB, voffB);
            PG8_WAIT_V(6); PG8_BAR; PG8_MMA(1, 1, At, B1); PG8_BAR;
            PG8_LDB(B0, 1, 0); PG8_SCHED; PG8_LDA(At, 1, 0); PG8_STAGE(PG8_SA(0, 1), a2 + hstepA, voffA);
            PG8_WAIT_L(8); PG8_BAR; PG8_WAIT_L(0); PG8_MMA(0, 0, At, B0); PG8_BAR; PG8_SCHED;
            PG8_LDB(B1, 1, 1); PG8_STAGE(PG8_SB(1, 0), b3, voffB);
            PG8_BAR; PG8_WAIT_L(0); PG8_MMA(0, 1, At, B1); PG8_BAR;
            PG8_LDA(At, 1, 1); PG8_STAGE(PG8_SA(1, 0), a3, voffA);
            PG8_BAR; PG8_WAIT_L(0); PG8_MMA(1, 0, At, B0); PG8_BAR; PG8_SCHED;
            PG8_STAGE(PG8_SB(1, 1), b3 + hstepB, voffB);
            PG8_WAIT_V(6); PG8_BAR; PG8_MMA(1, 1, At, B1); PG8_BAR;
            }
        }
        if constexpr (ALIGN_EPI) { if (wr == 0) PG8_BAR; }
        E(acc, cur, wr, wc, fr, fq, lds);
        if (!has_next) break;
#pragma unroll
        for (int a = 0; a < 2; ++a)
#pragma unroll
            for (int b = 0; b < 2; ++b)
#pragma unroll
                for (int m = 0; m < 4; ++m)
#pragma unroll
                    for (int n = 0; n < 2; ++n) acc[a][b][m][n] = (f32x4){0.f, 0.f, 0.f, 0.f};
        cur = nxt; cA = nA; cB = nB; ++ui;
        if constexpr (ALIGN_EPI) { if (wr == 1) PG8_BAR; }
    }
    PG8_WAIT_V(0);
    if constexpr (!ALIGN_EPI) { if (wr == 0) PG8_BAR; }
    PG8_BAR;
#undef PG8_SA
#undef PG8_SB
#undef PG8_STAGE
#undef PG8_LDA
#undef PG8_LDB
#undef PG8_MMA
#undef PG8_WAIT_V
#undef PG8_WAIT_L
#undef PG8_BAR
#undef PG8_SCHED
}
}

#ifndef PG8_SP2
#define PG8_SP2 true
#endif

struct TDesc { const float* W; bf16_t* WT; int K, N, row_off, item, scaled; };
__device__ __forceinline__ void p0_item_load(const TDesc& d, f32x4 (&v)[16], int lane) {
    const int nblk = d.N / 64, kb = d.item / nblk, nb = d.item % nblk, k0 = 64 * kb, n0 = 64 * nb;
    const int nn = (lane & 15) * 4;
#pragma unroll
    for (int i = 0; i < 16; ++i) { const int kk = 4 * i + (lane >> 4); v[i] = __builtin_nontemporal_load((const f32x4*)(d.W + (size_t)(k0 + kk) * d.N + n0 + nn)); }
}
__device__ __forceinline__ void p0_item_store(const TDesc& d, const f32x4 (&v)[16], LAS float* scr, int lane, const float* gs, const float* bs, float* c1, float* c2) {
    const int nblk = d.N / 64, kb = d.item / nblk, nb = d.item % nblk, k0 = 64 * kb, n0 = 64 * nb;
    const int nn = (lane & 15) * 4;
#pragma unroll
    for (int i = 0; i < 16; ++i) { const int kk = 4 * i + (lane >> 4); LAS float* q = scr + kk * 65 + nn; q[0] = v[i][0]; q[1] = v[i][1]; q[2] = v[i][2]; q[3] = v[i][3]; }
    asm volatile("s_waitcnt lgkmcnt(0)" ::: "memory");
    const int c = lane & 7;
    if (d.scaled) {
        const f32x4 ga = *(const f32x4*)(gs + k0 + 8 * c), gb = *(const f32x4*)(gs + k0 + 8 * c + 4), ba = *(const f32x4*)(bs + k0 + 8 * c), bb = *(const f32x4*)(bs + k0 + 8 * c + 4);
#pragma unroll
        for (int j = 0; j < 8; ++j) { const int n = (lane >> 3) + 8 * j; const LAS float* sp = scr + (8 * c) * 65 + n;
            const float w0 = sp[0 * 65], w1 = sp[1 * 65], w2 = sp[2 * 65], w3 = sp[3 * 65], w4 = sp[4 * 65], w5 = sp[5 * 65], w6 = sp[6 * 65], w7 = sp[7 * 65];
            u32x4 o; o.x = cvt_pk_bf16(w0 * ga[0], w1 * ga[1]); o.y = cvt_pk_bf16(w2 * ga[2], w3 * ga[3]); o.z = cvt_pk_bf16(w4 * gb[0], w5 * gb[1]); o.w = cvt_pk_bf16(w6 * gb[2], w7 * gb[3]);
            float s1 = ((bf_lo(o.x) + bf_hi(o.x)) + (bf_lo(o.y) + bf_hi(o.y))) + ((bf_lo(o.z) + bf_hi(o.z)) + (bf_lo(o.w) + bf_hi(o.w)));
            float s2 = ((w0 * ba[0] + w1 * ba[1]) + (w2 * ba[2] + w3 * ba[3])) + ((w4 * bb[0] + w5 * bb[1]) + (w6 * bb[2] + w7 * bb[3]));
            s1 += __shfl_xor(s1, 1); s1 += __shfl_xor(s1, 2); s1 += __shfl_xor(s1, 4); s2 += __shfl_xor(s2, 1); s2 += __shfl_xor(s2, 2); s2 += __shfl_xor(s2, 4);
            if (c == 0) { __hip_atomic_fetch_add(c1 + n0 + n, s1, __ATOMIC_RELAXED, __HIP_MEMORY_SCOPE_AGENT); __hip_atomic_fetch_add(c2 + n0 + n, s2, __ATOMIC_RELAXED, __HIP_MEMORY_SCOPE_AGENT); }
            *(u32x4*)(d.WT + (size_t)(d.row_off + n0 + n) * d.K + k0 + 8 * c) = o; }
    } else {
#pragma unroll
        for (int j = 0; j < 8; ++j) { const int n = (lane >> 3) + 8 * j; const LAS float* sp = scr + (8 * c) * 65 + n;
            u32x4 o; o.x = cvt_pk_bf16(sp[0 * 65], sp[1 * 65]); o.y = cvt_pk_bf16(sp[2 * 65], sp[3 * 65]); o.z = cvt_pk_bf16(sp[4 * 65], sp[5 * 65]); o.w = cvt_pk_bf16(sp[6 * 65], sp[7 * 65]);
            *(u32x4*)(d.WT + (size_t)(d.row_off + n0 + n) * d.K + k0 + 8 * c) = o; }
    }
    asm volatile("s_waitcnt lgkmcnt(0)" ::: "memory");
}

__device__ __forceinline__ void ln_rows_folded(const bf16_t* Z, const float* stats, const float* g2, const float* b2, const bf16_t* Y, float* O, const float* g, const float* b, int gw, int NGW, int lane) {
    for (int row = gw; row < T; row += NGW) {
        const f32x2 st = *(const f32x2*)(stats + 2 * (size_t)row);
        const float mean2 = st.x * (1.0f / D); const float rstd2 = 1.0f / sqrtf(fmaxf(st.y * (1.0f / D) - mean2 * mean2, 0.f) + LN_EPS);
        f32x4 v[8]; float s = 0.f;
#pragma unroll
        for (int j = 0; j < 8; ++j) {
            const u32x2 zw = *(const u32x2*)(Z + (size_t)row * D + 4 * lane + 256 * j); const u32x2 y = *(const u32x2*)(Y + (size_t)row * D + 4 * lane + 256 * j);
            const f32x4 g4 = *(const f32x4*)(g2 + 4 * lane + 256 * j), b4 = *(const f32x4*)(b2 + 4 * lane + 256 * j);
            const f32x4 z = {bf_lo(zw.x), bf_hi(zw.x), bf_lo(zw.y), bf_hi(zw.y)}; const f32x4 yy = {bf_lo(y.x), bf_hi(y.x), bf_lo(y.y), bf_hi(y.y)};
            v[j] = ((z - mean2) * rstd2 * g4 + b4) * ALPHA + yy;
            s += (v[j][0] + v[j][1]) + (v[j][2] + v[j][3]); }
        const float mean = wave_sum(s) * (1.0f / D); float s2 = 0.f;
#pragma unroll
        for (int j = 0; j < 8; ++j) { v[j] = v[j] - mean; s2 += (v[j][0] * v[j][0] + v[j][1] * v[j][1]) + (v[j][2] * v[j][2] + v[j][3] * v[j][3]); }
        const float rstd = 1.0f / sqrtf(wave_sum(s2) * (1.0f / D) + LN_EPS);
#pragma unroll
        for (int j = 0; j < 8; ++j) { const f32x4 g4 = *(const f32x4*)(g + 4 * lane + 256 * j), b4 = *(const f32x4*)(b + 4 * lane + 256 * j);
            __builtin_nontemporal_store(v[j] * rstd * g4 + b4, (f32x4*)(O + (size_t)row * D + 4 * lane + 256 * j)); }
    }
}
template <bool RBF>
__device__ __forceinline__ void ln_rows(const void* Rv, const bf16_t* Y, float* O, const float* g, const float* b, bf16_t* XBo, int gw, int NGW, int lane) {
    for (int row = gw; row < T; row += NGW) {
        const bf16_t* yr = Y + (size_t)row * D + 4 * lane;
        f32x4 v[8]; float s = 0.f;
#pragma unroll
        for (int j = 0; j < 8; ++j) {
            f32x4 r;
            if constexpr (RBF) { const u32x2 rw = *(const u32x2*)((const bf16_t*)Rv + (size_t)row * D + 4 * lane + 256 * j); r[0] = bf_lo(rw.x); r[1] = bf_hi(rw.x); r[2] = bf_lo(rw.y); r[3] = bf_hi(rw.y); }
            else r = __builtin_nontemporal_load((const f32x4*)((const float*)Rv + (size_t)row * D + 4 * lane + 256 * j));
            const u32x2 y = *(const u32x2*)(yr + 256 * j);
            v[j][0] = r[0] * ALPHA + bf_lo(y.x); v[j][1] = r[1] * ALPHA + bf_hi(y.x); v[j][2] = r[2] * ALPHA + bf_lo(y.y); v[j][3] = r[3] * ALPHA + bf_hi(y.y);
            s += (v[j][0] + v[j][1]) + (v[j][2] + v[j][3]); }
        const float mean = wave_sum(s) * (1.0f / D); float s2 = 0.f;
#pragma unroll
        for (int j = 0; j < 8; ++j) { v[j] = v[j] - mean; s2 += (v[j][0] * v[j][0] + v[j][1] * v[j][1]) + (v[j][2] * v[j][2] + v[j][3] * v[j][3]); }
        const float rstd = 1.0f / sqrtf(wave_sum(s2) * (1.0f / D) + LN_EPS);
#pragma unroll
        for (int j = 0; j < 8; ++j) { const f32x4 g4 = *(const f32x4*)(g + 4 * lane + 256 * j), b4 = *(const f32x4*)(b + 4 * lane + 256 * j);
            const f32x4 y = v[j] * rstd * g4 + b4;
            if (O) __builtin_nontemporal_store(y, (f32x4*)(O + (size_t)row * D + 4 * lane + 256 * j));
            if (XBo) { u32x2 w; w.x = cvt_pk_bf16(y[0], y[1]); w.y = cvt_pk_bf16(y[2], y[3]); *(u32x2*)(XBo + (size_t)row * D + 4 * lane + 256 * j) = w; } }
    }
}

#define XB_TMO      128
#define XB_XCNT(j)  (256  + 64 * (j))
#define XB_XSUB(j)  (1280 + 64 * (j))
#define XB_XGEN(j)  (2304 + 64 * (j))
#define XB_TOP      3328
#define XB_TOPGEN   3392
#define XCD_BAR_WORDS 3456
#define XB_SPIN_CAP (1u << 18)
__device__ __forceinline__ unsigned xb_ld(unsigned* p)              { return __hip_atomic_load(p, __ATOMIC_RELAXED, __HIP_MEMORY_SCOPE_AGENT); }
__device__ __forceinline__ unsigned xb_add(unsigned* p, unsigned v) { return __hip_atomic_fetch_add(p, v, __ATOMIC_RELAXED, __HIP_MEMORY_SCOPE_AGENT); }
__device__ __forceinline__ unsigned xb_xcc_id() { return (unsigned)__builtin_amdgcn_s_getreg((3 << 11) | 20) & 0xFu; }
#define XB_SPIN(cond, bar) do { unsigned _sp = 0; while (cond) { __builtin_amdgcn_s_sleep(1); \
    if ((++_sp & 255u) == 0u) { if (xb_ld(&(bar)[XB_TMO])) break; if (_sp > XB_SPIN_CAP) { atomicAdd(&(bar)[XB_TMO], 1u); break; } } } } while (0)
struct XcdBarrier { unsigned* bar; unsigned x; volatile LAS unsigned* st; };
__device__ __forceinline__ XcdBarrier xcd_barrier_post(unsigned* bar, volatile LAS unsigned* st) {
    XcdBarrier b; b.bar = bar; b.x = xb_xcc_id(); b.st = st;
    if (threadIdx.x == 0) (void)xb_add(&bar[XB_XCNT(b.x)], 1u);
    return b;
}
__device__ __forceinline__ void xcd_barrier_complete(unsigned* bar, unsigned x, unsigned& nloc, unsigned& nx) {
    const unsigned G = gridDim.x * gridDim.y * gridDim.z;
    unsigned sum, cnt, mine, sp = 0u;
    for (;;) {
        sum = 0u; cnt = 0u; mine = 0u;
#pragma unroll
        for (unsigned j = 0; j < 16; ++j) { const unsigned c = xb_ld(&bar[XB_XCNT(j)]); sum += c; cnt += (c > 0u) ? 1u : 0u; mine = (j == x) ? c : mine; }
        if (sum == G) break;
        __builtin_amdgcn_s_sleep(1);
        if ((++sp & 255u) == 0u) { if (xb_ld(&bar[XB_TMO])) break; if (sp > XB_SPIN_CAP) { atomicAdd(&bar[XB_TMO], 1u); break; } }
    }
    nloc = mine > 0u ? mine : 1u; nx = cnt > 0u ? cnt : 1u;
}
__device__ __forceinline__ void xcd_barrier(const XcdBarrier& b) {
    asm volatile("s_waitcnt vmcnt(0)" ::: "memory");
    __syncthreads();
    if (threadIdx.x == 0) {
        unsigned* bar = b.bar;
        __builtin_amdgcn_s_waitcnt(0);
        unsigned nloc = b.st[0], nx = b.st[1];
        if (nloc == 0u) { xcd_barrier_complete(bar, b.x, nloc, nx); b.st[0] = nloc; b.st[1] = nx; }
        const unsigned old = xb_add(&bar[XB_XSUB(b.x)], 1u);
        const unsigned gen = old / nloc;
        if (old + 1u == (gen + 1u) * nloc) {
            __builtin_amdgcn_fence(__ATOMIC_RELEASE, "agent");
            asm volatile("s_waitcnt vmcnt(0)" ::: "memory");
            const unsigned og = xb_add(&bar[XB_TOP], 1u);
            const unsigned tg = og / nx;
            if (og + 1u == (tg + 1u) * nx) xb_add(&bar[XB_TOPGEN], 1u);
            else XB_SPIN(xb_ld(&bar[XB_TOPGEN]) == tg, bar);
            __builtin_amdgcn_fence(__ATOMIC_ACQUIRE, "agent");
            xb_add(&bar[XB_XGEN(b.x)], 1u);
            asm volatile("s_waitcnt vmcnt(0)" ::: "memory");
        } else {
            XB_SPIN(xb_ld(&bar[XB_XGEN(b.x)]) == gen, bar);
            __builtin_amdgcn_fence(__ATOMIC_ACQUIRE, "agent");
            asm volatile("s_waitcnt vmcnt(0)" ::: "memory");
        }
    }
    __syncthreads();
}

struct Args { const float* in[26]; float* out; unsigned char* ws; int ph_lo, ph_hi; };
constexpr int N_PHASES = 15;

__global__ void __launch_bounds__(512, 2) fwd_mega(Args args) {
    extern __shared__ __attribute__((aligned(16))) unsigned char lds_raw[];
    LAS unsigned char* lds = (LAS unsigned char*)lds_raw;
    const int G = gridDim.x, bid = blockIdx.x;
    const int NGW = G * 8; const long NGT = (long)G * 512;
#define PHASE_IDS() int tid = threadIdx.x; asm volatile("" : "+v"(tid)); const int lane = tid & 63, wave = __builtin_amdgcn_readfirstlane(tid >> 6); \
    const int gw = bid * 8 + wave; const long gt = (long)bid * 512 + tid; (void)lane; (void)gw; (void)gt;
    unsigned char* ws = args.ws;
    const float* x = args.in[0]; const float* mem = args.in[1];
    bf16_t* WIN = (bf16_t*)(ws + WS_WIN); bf16_t* WOUT = (bf16_t*)(ws + WS_WOUT); bf16_t* WQ = (bf16_t*)(ws + WS_WQ); bf16_t* WK = (bf16_t*)(ws + WS_WK);
    bf16_t* WV = (bf16_t*)(ws + WS_WV); bf16_t* WO = (bf16_t*)(ws + WS_WO); bf16_t* WFF1 = (bf16_t*)(ws + WS_WFF1); bf16_t* WFF2 = (bf16_t*)(ws + WS_WFF2);
    bf16_t* WPOOL = (bf16_t*)(ws + WS_WPOOL); bf16_t* WAX = (bf16_t*)(ws + WS_WAX);
    bf16_t* MEMB = (bf16_t*)(ws + WS_MEMB); bf16_t* KB = (bf16_t*)(ws + WS_KB); bf16_t* VT = (bf16_t*)(ws + WS_VT);
    bf16_t* XB = (bf16_t*)(ws + WS_XB); unsigned short* BH = (unsigned short*)(ws + WS_BF); bf16_t* PROJ = (bf16_t*)(ws + WS_PROJ); bf16_t* Y3 = (bf16_t*)(ws + WS_Y3); bf16_t* QB = (bf16_t*)(ws + WS_Q); bf16_t* YB = (bf16_t*)(ws + WS_Q);
    bf16_t* PB = (bf16_t*)(ws + WS_PB); bf16_t* A2 = (bf16_t*)(ws + WS_A2); float* SUMP = (float*)(ws + WS_SUM); float* SUMH = SUMP + 4 * 64 * 1024;
    bf16_t* OB = (bf16_t*)(ws + WS_O); bf16_t* MIX = (bf16_t*)(ws + WS_MIX); bf16_t* MT = (bf16_t*)(ws + WS_MT); bf16_t* NT = (bf16_t*)(ws + WS_NT); unsigned short* AH = (unsigned short*)(ws + WS_AF); bf16_t* HB = (bf16_t*)(ws + WS_H);
    float* out = args.out;
    float* C1 = (float*)(ws + WS_CTL + CTL_C1); float* C2 = (float*)(ws + WS_CTL + CTL_C2); float* STATS2 = (float*)(ws + WS_CTL + CTL_STATS2);
    const int lo = args.ph_lo, hi = args.ph_hi;
#define IN(k) (lo <= (k) && (k) < hi)
#define SEAM(k) do { if (IN(k) && IN((k) + 1)) { xcd_barrier(bar); } } while (0)
    volatile LAS unsigned* bst = (volatile LAS unsigned*)(lds + LDS_BARST);
    if (threadIdx.x < 4) bst[threadIdx.x] = 0u;
    __syncthreads();
    XcdBarrier bar = xcd_barrier_post((unsigned*)(ws + WS_CTL) + 4096, bst);
    if (lo < -1) cg::this_grid().sync();

    if (IN(0)) for (int rep_ = 0; rep_ <= ((PROBE_DUP_MASK >> 0) & 1); ++rep_) {
        PHASE_IDS();
        LAS float* scr = (LAS float*)(lds + wave * 16640);
        constexpr int I_IN = 32 * 48, I_SQ = 32 * 32, I_F1 = 32 * 128, I_F2 = 128 * 32, I_POOL = 4 * 16, I_AX = 16 * 4;
        constexpr int NIT = I_IN + 4 * I_SQ + I_F1 + I_F2 + I_POOL + I_AX;
#define P0_RESOLVE(it_, d_) do { int r = (it_); \
            if (r < I_F1) { d_ = TDesc{args.in[22], WFF1, D, DFF, 0, r, 1}; break; } r -= I_F1; \
            if (r < I_F2) { d_ = TDesc{args.in[23], WFF2, DFF, D, 0, r, 0}; break; } r -= I_F2; \
            if (r < I_IN) { d_ = TDesc{args.in[2], WIN, D, NPROJ, 0, r, 0}; break; } r -= I_IN; \
            if (r < I_SQ) { d_ = TDesc{args.in[13], WOUT, D, D, 0, r, 0}; break; } r -= I_SQ; \
            if (r < I_SQ) { d_ = TDesc{args.in[17], WK, D, D, 0, r, 0}; break; } r -= I_SQ; \
            if (r < I_SQ) { d_ = TDesc{args.in[18], WV, D, D, 0, r, 0}; break; } r -= I_SQ; \
            if (r < I_SQ) { d_ = TDesc{args.in[19], WO, D, D, 0, r, 0}; break; } r -= I_SQ; \
            if (r < I_POOL) { const int g = r >> 4; d_ = TDesc{args.in[10] + (size_t)g * 65536, WPOOL + (size_t)g * 65536, 256, 256, 0, r & 15, 0}; break; } r -= I_POOL; \
            { const int mtx = r >> 2, h = mtx >> 1, which = mtx & 1;       \
              d_ = TDesc{args.in[which ? 7 : 5] + (size_t)h * 16384, WAX + (size_t)h * 32768, 128, 128, which * 128, r & 3, 0}; } } while (0)
        if (gw < NIT) {
            TDesc dc, dn; f32x4 vc[16], vn[16];
            P0_RESOLVE(gw, dc); p0_item_load(dc, vc, lane);
            for (int it = gw;;) {
                const int itn = it + NGW; const bool has_next = itn < NIT;
                if (has_next) { P0_RESOLVE(itn, dn); p0_item_load(dn, vn, lane); }
                p0_item_store(dc, vc, scr, lane, args.in[20], args.in[21], C1, C2);
                if (!has_next) break;
                dc = dn; it = itn;
#pragma unroll
                for (int i = 0; i < 16; ++i) vc[i] = vn[i];
            }
        }
#undef P0_RESOLVE
#pragma unroll 4
        for (long i = gt; i < (long)T * D / 8; i += NGT) { const f32x4 a = __builtin_nontemporal_load((const f32x4*)(x + i * 8)), b = __builtin_nontemporal_load((const f32x4*)(x + i * 8 + 4));
            u32x4 w; w.x = cvt_pk_bf16(a[0], a[1]); w.y = cvt_pk_bf16(a[2], a[3]); w.z = cvt_pk_bf16(b[0], b[1]); w.w = cvt_pk_bf16(b[2], b[3]); *(u32x4*)(XB + i * 8) = w; }
        for (long i = gt; i < (long)D * D / 8; i += NGT) { const f32x4 a = __builtin_nontemporal_load((const f32x4*)(args.in[16] + i * 8)), b = __builtin_nontemporal_load((const f32x4*)(args.in[16] + i * 8 + 4));
            u32x4 w; w.x = cvt_pk_bf16(a[0], a[1]); w.y = cvt_pk_bf16(a[2], a[3]); w.z = cvt_pk_bf16(b[0], b[1]); w.w = cvt_pk_bf16(b[2], b[3]); *(u32x4*)(WQ + i * 8) = w; }
        for (long i = gt; i < (long)NMEMROWS * D / 8; i += NGT) { const f32x4 a = *(const f32x4*)(mem + i * 8), b = *(const f32x4*)(mem + i * 8 + 4);
            u32x4 w; w.x = cvt_pk_bf16(a[0], a[1]); w.y = cvt_pk_bf16(a[2], a[3]); w.z = cvt_pk_bf16(b[0], b[1]); w.w = cvt_pk_bf16(b[2], b[3]); *(u32x4*)(MEMB + i * 8) = w; }
        __syncthreads();
    }
    SEAM(0);

    if (IN(1)) for (int rep_ = 0; rep_ <= ((PROBE_DUP_MASK >> 1) & 1); ++rep_) {
        { pg8::GSched S; S.init(XB, D, WIN, D, 1, 64, 12, G, bid); pg8::EpiBf16 E{PROJ, NPROJ, 0, 0, 1, 0};
          pg8::gemm_phase<pg8::EpiBf16, pg8::GSched, true, PG8_SP2>(lds, D, S, E); }
    }
    SEAM(1);

    if (IN(2)) for (int rep_ = 0; rep_ <= ((PROBE_DUP_MASK >> 2) & 1); ++rep_) {
        PHASE_IDS();
        const float* conv_w = args.in[3]; const float* conv_b = args.in[4];
        for (long it = gt; it < (long)(T / 32) * 256; it += NGT) {
            const int chunk = (int)(it & 255), r0 = (int)(it >> 8) * 32, pos0 = r0 & (SEQ - 1);
            if (chunk < 128) {
                const int g = chunk >> 5, w = 2 << g;
                const bf16_t* p = PROJ + (size_t)r0 * NPROJ + chunk * 8;
                float s[8];
#pragma unroll
                for (int j = 0; j < 8; ++j) s[j] = 0.f;
                for (int k = 1; k < w; ++k) { if (pos0 - k >= 0) { const u32x4 v = *(const u32x4*)(p - (size_t)k * NPROJ);
                    s[0] += bf_lo(v.x); s[1] += bf_hi(v.x); s[2] += bf_lo(v.y); s[3] += bf_hi(v.y); s[4] += bf_lo(v.z); s[5] += bf_hi(v.z); s[6] += bf_lo(v.w); s[7] += bf_hi(v.w); } }
#pragma unroll 8
                for (int t = 0; t < 32; ++t) {
                    const int pos = pos0 + t;
                    const u32x4 v = *(const u32x4*)(p + (size_t)t * NPROJ);
                    const float u[8] = {bf_lo(v.x), bf_hi(v.x), bf_lo(v.y), bf_hi(v.y), bf_lo(v.z), bf_hi(v.z), bf_lo(v.w), bf_hi(v.w)};
#pragma unroll
                    for (int j = 0; j < 8; ++j) s[j] += u[j];
                    const int cnt = (pos + 1) < w ? (pos + 1) : w; const float inv = 1.0f / (float)cnt;
                    u32x4 o; o.x = cvt_pk_bf16(s[0] * inv - u[0], s[1] * inv - u[1]); o.y = cvt_pk_bf16(s[2] * inv - u[2], s[3] * inv - u[3]);
                    o.z = cvt_pk_bf16(s[4] * inv - u[4], s[5] * inv - u[5]); o.w = cvt_pk_bf16(s[6] * inv - u[6], s[7] * inv - u[7]);
                    *(u32x4*)(A2 + (size_t)(r0 + t) * D + chunk * 8) = o;
                    if (pos + 1 - w >= 0) { const u32x4 q = *(const u32x4*)(p + ((long)t + 1 - w) * NPROJ);
                        s[0] -= bf_lo(q.x); s[1] -= bf_hi(q.x); s[2] -= bf_lo(q.y); s[3] -= bf_hi(q.y); s[4] -= bf_lo(q.z); s[5] -= bf_hi(q.z); s[6] -= bf_lo(q.w); s[7] -= bf_hi(q.w); }
                }
            } else {
                const int c = (chunk - 128) * 8;
                const bf16_t* p = PROJ + (size_t)r0 * NPROJ + 1024 + c;
                float cw[4][8], cb[8];
#pragma unroll
                for (int k = 0; k < 4; ++k) { const f32x4 w0 = *(const f32x4*)(conv_w + k * 1024 + c), w1 = *(const f32x4*)(conv_w + k * 1024 + c + 4);
                    cw[k][0] = w0[0]; cw[k][1] = w0[1]; cw[k][2] = w0[2]; cw[k][3] = w0[3]; cw[k][4] = w1[0]; cw[k][5] = w1[1]; cw[k][6] = w1[2]; cw[k][7] = w1[3]; }
                { const f32x4 b0 = *(const f32x4*)(conv_b + c), b1 = *(const f32x4*)(conv_b + c + 4); cb[0] = b0[0]; cb[1] = b0[1]; cb[2] = b0[2]; cb[3] = b0[3]; cb[4] = b1[0]; cb[5] = b1[1]; cb[6] = b1[2]; cb[7] = b1[3]; }
                const u32x4 zero = {0u, 0u, 0u, 0u};
                u32x4 v0 = zero, v1 = zero, v2 = zero;
                if (pos0 > 0) { v0 = *(const u32x4*)(p - 3 * (size_t)NPROJ); v1 = *(const u32x4*)(p - 2 * (size_t)NPROJ); v2 = *(const u32x4*)(p - (size_t)NPROJ); }
#pragma unroll 8
                for (int t = 0; t < 32; ++t) {
                    const u32x4 v3 = *(const u32x4*)(p + (size_t)t * NPROJ);
                    float s[8];
#pragma unroll
                    for (int j = 0; j < 8; ++j) s[j] = cb[j];
#define CONV_TAP(k, v) s[0] += cw[k][0] * bf_lo(v.x); s[1] += cw[k][1] * bf_hi(v.x); s[2] += cw[k][2] * bf_lo(v.y); s[3] += cw[k][3] * bf_hi(v.y); \
                       s[4] += cw[k][4] * bf_lo(v.z); s[5] += cw[k][5] * bf_hi(v.z); s[6] += cw[k][6] * bf_lo(v.w); s[7] += cw[k][7] * bf_hi(v.w);
                    CONV_TAP(0, v0) CONV_TAP(1, v1) CONV_TAP(2, v2) CONV_TAP(3, v3)
#undef CONV_TAP
                    u32x4 o; o.x = cvt_pk_bf16(s[0], s[1]); o.y = cvt_pk_bf16(s[2], s[3]); o.z = cvt_pk_bf16(s[4], s[5]); o.w = cvt_pk_bf16(s[6], s[7]);
                    *(u32x4*)(A2 + (size_t)(r0 + t) * D + 1024 + c) = o;
                    v0 = v1; v1 = v2; v2 = v3;
                }
            }
        }
    }
    SEAM(2);

    if (IN(3)) for (int rep_ = 0; rep_ <= ((PROBE_DUP_MASK >> 3) & 1); ++rep_) {
        if (bid < 32) { pg8::GSched S; S.init(MEMB, D, WK, D, 1, 4, 8, 32, bid); pg8::EpiBf16 E{KB, D, 0, 0, 1, 0};
          pg8::gemm_phase<pg8::EpiBf16, pg8::GSched, true, PG8_SP2>(lds, D, S, E); }
        else if (bid < 64) { pg8::GSched S; S.init(MEMB, D, WV, D, 1, 4, 8, 32, bid - 32); pg8::EpiBf16 E{VT, D, 0, 0, 1, 0};
          pg8::gemm_phase<pg8::EpiBf16, pg8::GSched, true, PG8_SP2>(lds, D, S, E); }
        else {
        const int G2 = G - 64, c2 = bid - 64;
        { pg8::GSched S; S.init(A2, D, WPOOL, 256, 4, 64, 1, G2, c2); S.ga1 = 256; S.gb1 = 65536; pg8::EpiPool E{MIX, args.in[11], args.in[12]};
          pg8::gemm_phase<pg8::EpiPool, pg8::GSched, true, PG8_SP2>(lds, 256, S, E); }
        { pg8::GSched S; S.init(A2 + 1024, D, WAX, 128, 8, 64, 1, G2, (c2 + 128) % G2); S.ga1 = 128; S.gb1 = 32768; pg8::EpiLru E{A2, args.in[6], args.in[8], args.in[9], AH, BH};
          pg8::gemm_phase<pg8::EpiLru, pg8::GSched, true, PG8_SP2>(lds, 128, S, E); }
        }
    }
    SEAM(3);

    if (IN(4)) for (int rep_ = 0; rep_ <= ((PROBE_DUP_MASK >> 4) & 1); ++rep_) {
        PHASE_IDS();
        for (int it = (int)gt; it < 4 * 64 * 512; it += (int)NGT) {
            const int c2 = it & 511, k = (it >> 9) & 63, b = it >> 15;
            const size_t o0 = ((size_t)b * SEQ + k * 64) * 1024 + 2 * c2;
            const unsigned short* pa = AH + o0; const unsigned short* pb = BH + o0;
            float h0 = 0.f, h1 = 0.f, P0 = 1.f, P1 = 1.f;
#pragma unroll 8
            for (int t = 0; t < 64; ++t) { const unsigned dw = *(const unsigned*)(pa + (size_t)t * 1024), bw = *(const unsigned*)(pb + (size_t)t * 1024);
                const float a0 = 1.0f - h_lo(dw), a1 = 1.0f - h_hi(dw); h0 = a0 * h0 + h_lo(bw); h1 = a1 * h1 + h_hi(bw); P0 *= a0; P1 *= a1; }
            *(f32x2*)(SUMP + (size_t)(b * 64 + k) * 1024 + 2 * c2) = (f32x2){P0, P1}; *(f32x2*)(SUMH + (size_t)(b * 64 + k) * 1024 + 2 * c2) = (f32x2){h0, h1};
        }
        __syncthreads();
        if (bid < 128) { pg8::GSched S; S.init(KB, D, WQ, D, 16, 1, 8, 128, bid); S.gdiv = 4; S.ga1 = 256L * D; S.ga0 = 512; S.gb1 = 0; S.gb0 = 512;
          pg8::EpiBf16 E{MT, D, 4L * 256 * D, 256L * D, 4, 0};
          pg8::gemm_phase<pg8::EpiBf16, pg8::GSched, true, PG8_SP2>(lds, 512, S, E); }
        else { pg8::GSched S; S.init(WO, D, VT, D, 16, 8, 1, 128, bid - 128); S.gdiv = 4; S.ga1 = 0; S.ga0 = 512; S.gb1 = 256L * D; S.gb0 = 512;
          pg8::EpiBf16 E{NT, 1024, 2048L * 1024, 256, 4, 0};
          pg8::gemm_phase<pg8::EpiBf16, pg8::GSched, true, PG8_SP2>(lds, 512, S, E); }
    }
    SEAM(4);

    if (IN(5)) for (int rep_ = 0; rep_ <= ((PROBE_DUP_MASK >> 5) & 1); ++rep_) {
        PHASE_IDS();
        for (int it = (int)gt; it < 4 * 64 * 512; it += (int)NGT) {
            const int c2 = it & 511, k = (it >> 9) & 63, b = it >> 15;
            const float* sp = SUMP + (size_t)b * 65536 + 2 * c2; const float* sh = SUMH + (size_t)b * 65536 + 2 * c2;
            float h0 = 0.f, h1 = 0.f;
#pragma unroll 8
            for (int kk = 0; kk < k; ++kk) { const f32x2 p = *(const f32x2*)(sp + kk * 1024), q = *(const f32x2*)(sh + kk * 1024); h0 = h0 * p.x + q.x; h1 = h1 * p.y + q.y; }
            const size_t r0 = (size_t)b * SEQ + k * 64;
            const unsigned short* pa = AH + r0 * 1024 + 2 * c2; const unsigned short* pb = BH + r0 * 1024 + 2 * c2;
            const bf16_t* pg = PROJ + r0 * NPROJ + 2048 + 2 * c2; bf16_t* po = MIX + r0 * D + 1024 + 2 * c2;
#pragma unroll 8
            for (int t = 0; t < 64; ++t) { const unsigned dw = *(const unsigned*)(pa + (size_t)t * 1024), bw = *(const unsigned*)(pb + (size_t)t * 1024), gw2 = *(const unsigned*)(pg + (size_t)t * NPROJ);
                h0 = (1.0f - h_lo(dw)) * h0 + h_lo(bw); h1 = (1.0f - h_hi(dw)) * h1 + h_hi(bw);
                *(unsigned*)(po + (size_t)t * D) = cvt_pk_bf16(h0 * gelu_tanh(bf_lo(gw2)), h1 * gelu_tanh(bf_hi(gw2))); }
        }
    }
    SEAM(5);

    if (IN(6)) for (int rep_ = 0; rep_ <= ((PROBE_DUP_MASK >> 6) & 1); ++rep_) {
        pg8::GSched S; S.init(MIX, D, WOUT, D, 1, 64, 8, G, bid); pg8::EpiBf16 E{YB, D, 0, 0, 1, 0};
        pg8::gemm_phase<pg8::EpiBf16, pg8::GSched, true, PG8_SP2>(lds, D, S, E);
    }
    SEAM(6);
    if (IN(7)) for (int rep_ = 0; rep_ <= ((PROBE_DUP_MASK >> 7) & 1); ++rep_) { PHASE_IDS(); ln_rows<false>(x, YB, nullptr, args.in[14], args.in[15], XB, gw, NGW, lane); }
    SEAM(7);
    if (IN(9)) {
        pg8::GSched S; S.init(XB, D, MT, D, 16, 16, 1, G, bid); S.gdiv = 4; S.ga1 = (long)SEQ * D; S.ga0 = 0; S.gb1 = 4L * 256 * D; S.gb0 = 256L * D;
        pg8::EpiSoftmax E{PB, 0.04419417382415922f * 1.4426950408889634f};
        pg8::gemm_phase<pg8::EpiSoftmax, pg8::GSched, true, PG8_SP2>(lds, D, S, E);
    }
    SEAM(9);
    if (IN(11)) {
        pg8::GSched S; S.init(PB, 1024, NT, 1024, 4, 16, 8, G, bid); S.ga1 = (long)SEQ * 1024; S.gb1 = 2048L * 1024; pg8::EpiResStat E{XB, STATS2, 16};
        pg8::gemm_phase<pg8::EpiResStat, pg8::GSched, true, PG8_SP2>(lds, 1024, S, E);
    }
    SEAM(11);
    constexpr size_t CH_ROWS = T / 2;
    if (IN(13)) {
        { pg8::GSched S; S.init(XB, D, WFF1, D, 1, 32, 32, G, bid); S.wgm = 4; pg8::EpiFF1 E{HB, STATS2, C1, C2, 0};
          pg8::gemm_phase<pg8::EpiFF1, pg8::GSched, true, PG8_SP2>(lds, D, S, E); }
        xcd_barrier(bar);
        { pg8::GSched S; S.init(HB, DFF, WFF2, DFF, 1, 32, 8, G, bid); S.wgm = 4; pg8::EpiBf16 E{Y3, D, 0, 0, 1, 0};
          pg8::gemm_phase<pg8::EpiBf16, pg8::GSched, true, PG8_SP2>(lds, DFF, S, E); }
        { pg8::GSched S; S.init(XB + CH_ROWS * D, D, WFF1, D, 1, 32, 32, G, bid); S.wgm = 4; pg8::EpiFF1 E{HB + CH_ROWS * DFF, STATS2, C1, C2, (int)CH_ROWS};
          pg8::gemm_phase<pg8::EpiFF1, pg8::GSched, true, PG8_SP2>(lds, D, S, E); }
    }
    SEAM(13);
    if (IN(14)) {
        pg8::GSched S; S.init(HB + CH_ROWS * DFF, DFF, WFF2, DFF, 1, 32, 8, G, bid); S.wgm = 4; pg8::EpiBf16 E{Y3 + CH_ROWS * D, D, 0, 0, 1, 0};
        pg8::gemm_phase<pg8::EpiBf16, pg8::GSched, true, PG8_SP2>(lds, DFF, S, E);
    }
    SEAM(14);
    if (IN(15)) for (int rep_ = 0; rep_ <= ((PROBE_DUP_MASK >> 15) & 1); ++rep_) { PHASE_IDS(); ln_rows_folded(XB, STATS2, args.in[20], args.in[21], Y3, out, args.in[24], args.in[25], gw, NGW, lane); }
#undef IN
#undef SEAM
}

extern "C" void kernel_launch(void* const* d_in, const int* in_sizes, int n_in, void* d_out, int out_size, void* d_ws, size_t ws_size, hipStream_t stream) {
    static int grid = 0;
    if (grid == 0) {
        if (n_in != 26 || out_size != T * D || ws_size < WS_END) { fprintf(stderr, "kernel_launch: unexpected shapes (n_in %d out %d ws %zu)\n", n_in, out_size, ws_size); grid = -1; return; }
        int dev = 0, cus = 0, per_cu = 0;
        (void)hipGetDevice(&dev);
        (void)hipDeviceGetAttribute(&cus, hipDeviceAttributeMultiprocessorCount, dev);
        if (hipFuncSetAttribute((const void*)fwd_mega, hipFuncAttributeMaxDynamicSharedMemorySize, LDS_BYTES) != hipSuccess) { fprintf(stderr, "kernel_launch: hipFuncSetAttribute failed\n"); grid = -1; return; }
        if (hipOccupancyMaxActiveBlocksPerMultiprocessor(&per_cu, (const void*)fwd_mega, 512, LDS_BYTES) != hipSuccess || per_cu < 1) { fprintf(stderr, "kernel_launch: occupancy query says %d\n", per_cu); grid = -1; return; }
        grid = cus;
        if (grid % 8 != 0 || grid > 1024) { fprintf(stderr, "kernel_launch: unexpected CU count %d\n", cus); }
    }
    if (grid < 0) return;
    if (hipMemsetAsync((char*)d_ws + WS_CTL, 0, CTL_ZERO, stream) != hipSuccess) { fprintf(stderr, "kernel_launch: memset failed\n"); return; }
    Args a{};
    for (int i = 0; i < 26; ++i) a.in[i] = (const float*)d_in[i];
    a.out = (float*)d_out; a.ws = (unsigned char*)d_ws;
#if MK_N_LAUNCHES == 1
#if PROBE_PREFIX >= 0
    { a.ph_lo = 0; a.ph_hi = PROBE_PREFIX + 1; void* kargs0[] = {&a};
      (void)hipLaunchCooperativeKernel((const void*)fwd_mega, dim3(grid), dim3(512), kargs0, LDS_BYTES, stream);
      (void)hipMemsetAsync((char*)d_ws + WS_CTL, 0, CTL_ZERO, stream); }
#endif
    a.ph_lo = 0; a.ph_hi = N_PHASES + 1;
    void* kargs[] = {&a};
    hipError_t e = hipLaunchCooperativeKernel((const void*)fwd_mega, dim3(grid), dim3(512), kargs, LDS_BYTES, stream);
    if (e != hipSuccess) fprintf(stderr, "kernel_launch: cooperative launch failed: %s (grid %d)\n", hipGetErrorString(e), grid);
#else
    for (int p = 0; p <= N_PHASES; ++p) { a.ph_lo = p; a.ph_hi = p + 1; hipLaunchKernelGGL(fwd_mega, dim3(grid), dim3(512), LDS_BYTES, stream, a); }
#endif
}
```
